# Optimizing an MI355X kernel written in HIP

```python
import jax, jax.numpy as jnp
from jax import lax
import numpy as np

D_MODEL = 1024
BATCH = 8
SEQ = 2048
DEPTH = 1
DEC_BATCH = 128
DEC_SEQ = 8
PAST_LEN = 16384
PAGE_SIZE = 128

POOL_WINDOWS = (2, 4, 8, 16)
N_POOL_GROUPS = 4
D_POOL_GROUP = D_MODEL // 8
D_POOL = N_POOL_GROUPS * D_POOL_GROUP
POOL_PAD = max(POOL_WINDOWS) - 1
CHUNK = 128
N_SGU_HEADS = 4
D_SGU = D_MODEL // 2
D_SGU_HEAD = D_SGU // N_SGU_HEADS
D_IN = D_POOL + 2 * D_SGU + 2 * D_MODEL
D_FF = ((8 * D_MODEL // 3 + 255) // 256) * 256
CONV_K = 3
EPS = 1e-6

kernel_name = "gated_pool_sgu_convffn_step"


def _rmsnorm(x, g):
    xf = x.astype(jnp.float32)
    r = lax.rsqrt(jnp.mean(xf * xf, axis=-1, keepdims=True) + EPS)
    return (xf * r).astype(x.dtype) * g


def _pool_branch(p_ext, T, full_windows, pool_w, pool_scale):
    B = p_ext.shape[0]
    cs = jnp.cumsum(p_ext.astype(jnp.float32), axis=1)
    cs = jnp.pad(cs, ((0, 0), (1, 0), (0, 0)))
    x_tok = p_ext[:, POOL_PAD:].astype(jnp.float32)
    t = jnp.arange(T, dtype=jnp.float32)[:, None]
    outs = []
    for g, w in enumerate(POOL_WINDOWS):
        lo, hi = g * D_POOL_GROUP, (g + 1) * D_POOL_GROUP
        s = cs[:, POOL_PAD + 1:POOL_PAD + 1 + T, lo:hi] - cs[:, POOL_PAD + 1 - w:POOL_PAD + 1 - w + T, lo:hi]
        cnt = jnp.full_like(t, float(w)) if full_windows else jnp.minimum(float(w), t + 1.0)
        outs.append(s / cnt - x_tok[..., lo:hi])
    d = jnp.stack(outs, axis=2).astype(p_ext.dtype)
    y = jnp.einsum('btgc,gcd->btgd', d, pool_w).reshape(B, T, D_POOL)
    return y * pool_scale


def _sgu_branch(z, n_chunks, L, sgu_norm_g, sgu_w, sgu_b):
    B, T, _ = z.shape
    u, v = z[..., :D_SGU], z[..., D_SGU:]
    v = _rmsnorm(v, sgu_norm_g)
    vh = v.reshape(B, n_chunks, L, N_SGU_HEADS, D_SGU_HEAD)
    mask = jnp.tril(jnp.ones((L, L), dtype=bool))
    w_s = jnp.where(mask[None], sgu_w[:, :L, :L], jnp.zeros((), sgu_w.dtype))
    mix = jnp.einsum('hts,bcshd->bcthd', w_s, vh) + jnp.transpose(sgu_b[:, :L])[None, None, :, :, None]
    out = u * mix.reshape(B, T, D_SGU)
    return out, v


def _layer(x, pool_prev, conv_prev, full_windows, n_chunks, L,
           norm1_g, w_in, pool_w, pool_scale, w_pool_out, sgu_norm_g, sgu_w, sgu_b,
           w_sgu_out, w_o, norm2_g, ffn_w_up, ffn_w_gate, ffn_conv_w, ffn_conv_b, ffn_w_down):
    B, T, _ = x.shape
    h = _rmsnorm(x, norm1_g)
    zin = h @ w_in
    p_in = zin[..., :D_POOL]
    z_sgu = zin[..., D_POOL:D_POOL + 2 * D_SGU]
    g_in = zin[..., D_POOL + 2 * D_SGU:]
    p_ext = jnp.concatenate([pool_prev.astype(p_in.dtype), p_in], axis=1)
    a_out = _pool_branch(p_ext, T, full_windows, pool_w, pool_scale) @ w_pool_out
    s_out, v_rows = _sgu_branch(jax.nn.gelu(z_sgu), n_chunks, L, sgu_norm_g, sgu_w, sgu_b)
    b_out = s_out @ w_sgu_out
    gates = jax.nn.sigmoid(g_in.astype(jnp.float32)).astype(x.dtype)
    ga, gb = gates[..., :D_MODEL], gates[..., D_MODEL:]
    x = x + (ga * a_out + gb * b_out) @ w_o
    h2 = _rmsnorm(x, norm2_g)
    a = h2 @ ffn_w_up
    ext = jnp.concatenate([conv_prev.astype(a.dtype), a], axis=1)
    c = ext[:, 0:T] * ffn_conv_w[0]
    for k in range(1, CONV_K):
        c = c + ext[:, k:k + T] * ffn_conv_w[k]
    f = jax.nn.gelu(c + ffn_conv_b) * (h2 @ ffn_w_gate)
    x = x + f @ ffn_w_down
    return x, p_ext[:, -POOL_PAD:], ext[:, -(CONV_K - 1):], v_rows


def setup_inputs(seed: int = 0) -> dict:
    key = jax.random.key(seed)
    ks = jax.random.split(key, 24)
    f32 = jnp.float32
    n = lambda k, s, sc: jax.random.normal(k, s, f32) * sc
    return {
        "x_prompt": n(ks[0], (BATCH, SEQ, D_MODEL), 1.0),
        "x_sample": n(ks[1], (DEC_BATCH, DEC_SEQ, D_MODEL), 1.0),
        "state_pool": n(ks[2], (DEPTH, DEC_BATCH, POOL_PAD, D_POOL), 1.0),
        "state_ffn_conv": n(ks[3], (DEPTH, DEC_BATCH, CONV_K - 1, D_FF), 1.0),
        "norm1_g": 1.0 + n(ks[4], (DEPTH, D_MODEL), 0.02),
        "w_in": n(ks[5], (DEPTH, D_MODEL, D_IN), D_MODEL ** -0.5),
        "pool_w": n(ks[6], (DEPTH, N_POOL_GROUPS, D_POOL_GROUP, D_POOL_GROUP), D_POOL_GROUP ** -0.5),
        "pool_scale": 1.0 + n(ks[7], (DEPTH, D_POOL), 0.02),
        "w_pool_out": n(ks[8], (DEPTH, D_POOL, D_MODEL), D_POOL ** -0.5),
        "sgu_norm_g": 1.0 + n(ks[9], (DEPTH, D_SGU), 0.02),
        "sgu_w": n(ks[10], (DEPTH, N_SGU_HEADS, CHUNK, CHUNK), CHUNK ** -0.5),
        "sgu_b": 1.0 + n(ks[11], (DEPTH, N_SGU_HEADS, CHUNK), 0.1),
        "w_sgu_out": n(ks[12], (DEPTH, D_SGU, D_MODEL), D_SGU ** -0.5),
        "w_o": n(ks[13], (DEPTH, D_MODEL, D_MODEL), D_MODEL ** -0.5),
        "norm2_g": 1.0 + n(ks[14], (DEPTH, D_MODEL), 0.02),
        "ffn_w_up": n(ks[15], (DEPTH, D_MODEL, D_FF), D_MODEL ** -0.5),
        "ffn_w_gate": n(ks[16], (DEPTH, D_MODEL, D_FF), D_MODEL ** -0.5),
        "ffn_conv_w": n(ks[17], (DEPTH, CONV_K, D_FF), CONV_K ** -0.5),
        "ffn_conv_b": n(ks[18], (DEPTH, D_FF), 0.02),
        "ffn_w_down": n(ks[19], (DEPTH, D_FF, D_MODEL), D_FF ** -0.5),
        "final_norm_g": 1.0 + n(ks[20], (D_MODEL,), 0.02),
    }


def reference(x_prompt, x_sample, state_pool, state_ffn_conv, norm1_g, w_in, pool_w, pool_scale,
              w_pool_out, sgu_norm_g, sgu_w, sgu_b, w_sgu_out, w_o, norm2_g, ffn_w_up, ffn_w_gate,
              ffn_conv_w, ffn_conv_b, ffn_w_down, final_norm_g):
    B, T = x_prompt.shape[0], x_prompt.shape[1]
    DB, TS = x_sample.shape[0], x_sample.shape[1]
    xp, xs = x_prompt, x_sample
    pool_p, pool_s, conv_p, conv_s, v_s = [], [], [], [], []
    for l in range(DEPTH):
        w = (norm1_g[l], w_in[l], pool_w[l], pool_scale[l], w_pool_out[l], sgu_norm_g[l], sgu_w[l],
             sgu_b[l], w_sgu_out[l], w_o[l], norm2_g[l], ffn_w_up[l], ffn_w_gate[l], ffn_conv_w[l],
             ffn_conv_b[l], ffn_w_down[l])
        zp_pool = jnp.zeros((B, POOL_PAD, D_POOL), xp.dtype)
        zp_conv = jnp.zeros((B, CONV_K - 1, D_FF), xp.dtype)
        xp, npool_p, nconv_p, _ = _layer(xp, zp_pool, zp_conv, False, T // CHUNK, CHUNK, *w)
        xs, npool_s, nconv_s, v_rows = _layer(xs, state_pool[l], state_ffn_conv[l], True, 1, TS, *w)
        pool_p.append(npool_p); pool_s.append(npool_s)
        conv_p.append(nconv_p); conv_s.append(nconv_s); v_s.append(v_rows)
    y_prompt = _rmsnorm(xp, final_norm_g)
    y_sample = _rmsnorm(xs, final_norm_g)
    new_pool_prompt = jnp.stack(pool_p, axis=0)
    new_pool_sample = jnp.stack(pool_s, axis=0)
    new_conv_prompt = jnp.stack(conv_p, axis=0)
    new_conv_sample = jnp.stack(conv_s, axis=0)
    new_sgu_v_sample = jnp.stack(v_s, axis=0)
    return (y_prompt, y_sample, new_pool_prompt, new_pool_sample, new_conv_prompt, new_conv_sample, new_sgu_v_sample)
```

```cpp
#include <hip/hip_runtime.h>
#include <hip/hip_cooperative_groups.h>
#include <cstdio>
namespace cg = cooperative_groups;
namespace pg8 {
#define PG8_LAS __attribute__((address_space(3)))
typedef unsigned short bf16_t;
typedef short bf16x8 __attribute__((ext_vector_type(8)));
typedef float f32x4 __attribute__((ext_vector_type(4)));
typedef unsigned u32x4 __attribute__((ext_vector_type(4)));
constexpr int BM = 256, BK = 64, HALF = 128, HTB = HALF * BK * 2  , STAGE_BYTES = 8 * HTB, NXCD = 8, WGM = 8;

__host__ __device__ __forceinline__ int lds_byte(int r, int c) { const int st = (r >> 4) * 2 + (c >> 5), rr = r & 15, cc = c & 31, ob = rr * 64 + cc * 2; return st * 1024 + (ob ^ (((ob >> 9) & 1) << 5)); }
__host__ __device__ __forceinline__ void stage_rc(int b, int& R, int& C) { const int st = b / 1024, sb = b % 1024, swz = sb ^ (((sb >> 9) & 1) << 5); R = (st >> 1) * 16 + swz / 64; C = (st & 1) * 32 + (swz % 64) / 2; }
__host__ __device__ __forceinline__ int perm32(int rho) { const int n = rho >> 4, i = rho & 15; return 8 * (i >> 2) + 4 * n + (i & 3); }

struct Unit { int pm, pn, ko; };
struct Gemm { const bf16_t* A; const bf16_t* Bt; int M, N, K, ld; };

struct StaticOrder {
    int nM, nN, nwg, G, c;
    __host__ __device__ void init(int M, int N, int G_, int c_) { nM = M / BM; nN = N / BM; nwg = nM * nN; G = G_; c = c_; }
    __host__ __device__ bool next(int i, Unit& u) const {
        const long L = (long)i * G + c; if (L >= nwg) return false;
        int wgid = (int)L; { const int q = nwg / NXCD, r = nwg % NXCD, xcd = wgid % NXCD, off = wgid / NXCD; wgid = (xcd < r ? xcd * (q + 1) : r * (q + 1) + (xcd - r) * q) + off; }
        const int nig = WGM * nN, gid = wgid / nig, fm = gid * WGM, gsz = (nM - fm) < WGM ? (nM - fm) : WGM;
        u.pm = fm + ((wgid % nig) % gsz); u.pn = (wgid % nig) / gsz; u.ko = 0; return true;
    }
    __device__ __forceinline__ void a_ready(const Unit&) const {}
    __device__ __forceinline__ void done(const Unit&) const {}
};
struct SplitKOrder {
    int nM, nN, nS, kext, G, c;
    __host__ __device__ void init(int M, int N, int nS_, int kext_, int G_, int c_) { nM = M / BM; nN = N / BM; nS = nS_; kext = kext_; G = G_; c = c_; }
    __host__ __device__ bool next(int i, Unit& u) const { const int L = i * G + c; if (L >= nM * nN * nS) return false; const int ks = L / (nM * nN), rem = L - ks * (nM * nN); u.pm = rem % nM; u.pn = rem / nM; u.ko = ks * kext; return true; }
    __device__ __forceinline__ void a_ready(const Unit&) const {}
    __device__ __forceinline__ void done(const Unit&) const {}
};
typedef __bf16 bf16x2_t __attribute__((ext_vector_type(2)));
typedef float f32x2_t __attribute__((ext_vector_type(2)));
__device__ __forceinline__ unsigned cvt_pk_bf16(float lo, float hi) { f32x2_t v = {lo, hi}; bf16x2_t b = __builtin_convertvector(v, bf16x2_t); return __builtin_bit_cast(unsigned, b); }
typedef float f32x2 __attribute__((ext_vector_type(2)));
template <class Epi, class Sched, bool ALIGN_EPI = false, bool SP2 = false>
__device__ __forceinline__ void gemm_phase(PG8_LAS unsigned char* lds, const Gemm g, const Sched& S, const Epi& E) {
    const int tid = threadIdx.x, wid = __builtin_amdgcn_readfirstlane(tid >> 6), lane = tid & 63, wr = wid >> 2, wc = wid & 3, fr = lane & 15, fq = lane >> 4;
    const int K = g.ld, nt = g.K / BK;
    unsigned voffA[2], voffB[2];
#pragma unroll
    for (int i = 0; i < 2; ++i) { int R, C; stage_rc(tid * 16 + i * 8192, R, C); const int Rb = Epi::PERM ? ((R & ~31) + perm32(R & 31)) : R;
        voffA[i] = (unsigned)(R * K + C) * 2u; voffB[i] = (unsigned)(Rb * K + C) * 2u; }
    const size_t kstep = (size_t)(BK * 2);
    const size_t hstep = (size_t)HALF * K * 2;
    const size_t tstep = 2 * hstep;
    const unsigned ldsw = (unsigned)wid * 1024u;
    const int aoff = lds_byte(wr * 64 + fr, fq * 8), boff = lds_byte(wc * 32 + fr, fq * 8);
#define PG8_SA(b, h) (((b) * 2 + (h)) * HTB)
#define PG8_SB(b, h) ((4 + (b) * 2 + (h)) * HTB)
#define PG8_STAGE(bufoff, gbase, voff) do { _Pragma("unroll") for (int _i = 0; _i < 2; ++_i) \
        __builtin_amdgcn_global_load_lds((const unsigned*)((const char*)(gbase) + (voff)[_i]), (PG8_LAS unsigned*)(lds + (bufoff) + ldsw + _i * 8192), 16, 0, 0); } while (0)
#define PG8_LDA(dst, b, h) do { _Pragma("unroll") for (int m = 0; m < 4; ++m) _Pragma("unroll") for (int k = 0; k < 2; ++k) dst[m][k] = *(const PG8_LAS bf16x8*)(lds + PG8_SA(b, h) + aoff + m * 2048 + k * 1024); } while (0)
#define PG8_LDB(dst, b, h) do { _Pragma("unroll") for (int n = 0; n < 2; ++n) _Pragma("unroll") for (int k = 0; k < 2; ++k) dst[n][k] = *(const PG8_LAS bf16x8*)(lds + PG8_SB(b, h) + boff + n * 2048 + k * 1024); } while (0)
#define PG8_MMA(ai, bj, At, Bt) do { __builtin_amdgcn_s_setprio(1); _Pragma("unroll") for (int m = 0; m < 4; ++m) _Pragma("unroll") for (int n = 0; n < 2; ++n) _Pragma("unroll") for (int k = 0; k < 2; ++k) \
        acc[ai][bj][m][n] = __builtin_amdgcn_mfma_f32_16x16x32_bf16(Bt[n][k], At[m][k], acc[ai][bj][m][n], 0, 0, 0); __builtin_amdgcn_s_setprio(0); } while (0)
#define PG8_WAIT_V(n) asm volatile("s_waitcnt vmcnt(" #n ")" ::: "memory")
#define PG8_WAIT_L(n) asm volatile("s_waitcnt lgkmcnt(" #n ")" ::: "memory")
#define PG8_BAR __builtin_amdgcn_s_barrier()
#define PG8_SCHED __builtin_amdgcn_sched_barrier(0)
    Unit cur, nxt; int ui = 0;
    if (!S.next(0, cur)) return;
    f32x4 acc[2][2][4][2];
#pragma unroll
    for (int a = 0; a < 2; ++a)
#pragma unroll
        for (int b = 0; b < 2; ++b)
#pragma unroll
            for (int m = 0; m < 4; ++m)
#pragma unroll
                for (int n = 0; n < 2; ++n) acc[a][b][m][n] = (f32x4){0.f, 0.f, 0.f, 0.f};
    bf16x8 At[4][2], B0[2][2], B1[2][2];
    const char* cA = (const char*)g.A + (size_t)cur.pm * tstep + (size_t)cur.ko * 2; const char* cB = (const char*)g.Bt + (size_t)cur.pn * tstep + (size_t)cur.ko * 2;
    S.a_ready(cur);
    if constexpr (SP2) {
        PG8_STAGE(PG8_SB(0, 0), cB, voffB); PG8_STAGE(PG8_SB(0, 1), cB + hstep, voffB); PG8_STAGE(PG8_SA(0, 0), cA, voffA); PG8_STAGE(PG8_SA(0, 1), cA + hstep, voffA);
        if (wr == 1) PG8_BAR;
        PG8_WAIT_V(2); PG8_BAR;
        PG8_STAGE(PG8_SB(1, 0), cB + kstep, voffB); PG8_STAGE(PG8_SA(1, 0), cA + kstep, voffA); PG8_STAGE(PG8_SB(1, 1), cB + hstep + kstep, voffB);
        PG8_WAIT_V(6); PG8_BAR;
    } else {
        PG8_STAGE(PG8_SB(0, 0), cB, voffB); PG8_STAGE(PG8_SA(0, 0), cA, voffA); PG8_STAGE(PG8_SB(0, 1), cB + hstep, voffB); PG8_STAGE(PG8_SA(0, 1), cA + hstep, voffA);
        if (wr == 1) PG8_BAR;
        PG8_WAIT_V(4); PG8_BAR;
        PG8_STAGE(PG8_SB(1, 0), cB + kstep, voffB); PG8_STAGE(PG8_SA(1, 0), cA + kstep, voffA); PG8_STAGE(PG8_SB(1, 1), cB + hstep + kstep, voffB);
        PG8_WAIT_V(6); PG8_BAR;
    }
    for (;;) {
        const bool has_next = S.next(ui + 1, nxt);
        const char* nA = has_next ? (const char*)g.A + (size_t)nxt.pm * tstep + (size_t)nxt.ko * 2 : cA; const char* nB = has_next ? (const char*)g.Bt + (size_t)nxt.pn * tstep + (size_t)nxt.ko * 2 : cB;
        for (int t = 0; t < nt; t += 2) {
            const bool last = (t == nt - 2);
            const char* a1 = cA + (size_t)(t + 1) * kstep;
            const char* a2 = last ? nA : cA + (size_t)(t + 2) * kstep; const char* b2 = last ? nB : cB + (size_t)(t + 2) * kstep;
            const char* a3 = a2 + kstep; const char* b3 = b2 + kstep;
            if (last && has_next) S.a_ready(nxt);
            if constexpr (SP2) {
            PG8_LDB(B0, 0, 0); PG8_LDB(B1, 0, 1); PG8_SCHED; PG8_LDA(At, 0, 0); PG8_STAGE(PG8_SA(1, 1), a1 + hstep, voffA);
            PG8_WAIT_V(8); PG8_WAIT_L(0); PG8_BAR; PG8_MMA(0, 0, At, B0); PG8_MMA(0, 1, At, B1); PG8_BAR; PG8_SCHED;
            PG8_LDA(At, 0, 1); PG8_STAGE(PG8_SB(0, 0), b2, voffB); PG8_STAGE(PG8_SB(0, 1), b2 + hstep, voffB); PG8_STAGE(PG8_SA(0, 0), a2, voffA);
            PG8_WAIT_V(8); PG8_WAIT_L(0); PG8_BAR; PG8_MMA(1, 0, At, B0); PG8_MMA(1, 1, At, B1); PG8_BAR; PG8_SCHED;
            PG8_LDB(B0, 1, 0); PG8_LDB(B1, 1, 1); PG8_SCHED; PG8_LDA(At, 1, 0); PG8_STAGE(PG8_SA(0, 1), a2 + hstep, voffA);
            PG8_WAIT_V(8); PG8_WAIT_L(0); PG8_BAR; PG8_MMA(0, 0, At, B0); PG8_MMA(0, 1, At, B1); PG8_BAR; PG8_SCHED;
            PG8_LDA(At, 1, 1); PG8_STAGE(PG8_SB(1, 0), b3, voffB); PG8_STAGE(PG8_SB(1, 1), b3 + hstep, voffB); PG8_STAGE(PG8_SA(1, 0), a3, voffA);
            PG8_WAIT_V(8); PG8_WAIT_L(0); PG8_BAR; PG8_MMA(1, 0, At, B0); PG8_MMA(1, 1, At, B1); PG8_BAR; PG8_SCHED;
            } else {
            PG8_LDB(B0, 0, 0); PG8_SCHED; PG8_LDA(At, 0, 0); PG8_STAGE(PG8_SA(1, 1), a1 + hstep, voffA);
            PG8_WAIT_L(8); PG8_BAR; PG8_WAIT_L(0); PG8_MMA(0, 0, At, B0); PG8_BAR; PG8_SCHED;
            PG8_LDB(B1, 0, 1); PG8_STAGE(PG8_SB(0, 0), b2, voffB);
            PG8_BAR; PG8_WAIT_L(0); PG8_MMA(0, 1, At, B1); PG8_BAR;
            PG8_LDA(At, 0, 1); PG8_STAGE(PG8_SA(0, 0), a2, voffA);
            PG8_BAR; PG8_WAIT_L(0); PG8_MMA(1, 0, At, B0); PG8_BAR; PG8_SCHED;
            PG8_STAGE(PG8_SB(0, 1), b2 + hstep, voffB);
            PG8_WAIT_V(6); PG8_BAR; PG8_MMA(1, 1, At, B1); PG8_BAR;
            PG8_LDB(B0, 1, 0); PG8_SCHED; PG8_LDA(At, 1, 0); PG8_STAGE(PG8_SA(0, 1), a2 + hstep, voffA);
            PG8_WAIT_L(8); PG8_BAR; PG8_WAIT_L(0); PG8_MMA(0, 0, At, B0); PG8_BAR; PG8_SCHED;
            PG8_LDB(B1, 1, 1); PG8_STAGE(PG8_SB(1, 0), b3, voffB);
            PG8_BAR; PG8_WAIT_L(0); PG8_MMA(0, 1, At, B1); PG8_BAR;
            PG8_LDA(At, 1, 1); PG8_STAGE(PG8_SA(1, 0), a3, voffA);
            PG8_BAR; PG8_WAIT_L(0); PG8_MMA(1, 0, At, B0); PG8_BAR; PG8_SCHED;
            PG8_STAGE(PG8_SB(1, 1), b3 + hstep, voffB);
            PG8_WAIT_V(6); PG8_BAR; PG8_MMA(1, 1, At, B1); PG8_BAR;
            }
        }
        if constexpr (ALIGN_EPI) { if (wr == 0) PG8_BAR; }
        if constexpr (!Epi::AFTER_DRAIN) { E(acc, cur, wr, wc, fr, fq); S.done(cur); }
        if (!has_next) break;
#pragma unroll
        for (int a = 0; a < 2; ++a)
#pragma unroll
            for (int b = 0; b < 2; ++b)
#pragma unroll
                for (int m = 0; m < 4; ++m)
#pragma unroll
                    for (int n = 0; n < 2; ++n) acc[a][b][m][n] = (f32x4){0.f, 0.f, 0.f, 0.f};
        cur = nxt; cA = nA; cB = nB; ++ui;
        if constexpr (ALIGN_EPI) { if (wr == 1) PG8_BAR; }
    }
    PG8_WAIT_V(0);
    if constexpr (!ALIGN_EPI) { if (wr == 0) PG8_BAR; }
    PG8_BAR;
    if constexpr (Epi::AFTER_DRAIN) { E.fused(acc, cur, wr, wc, fr, fq, lds, wid, lane); S.done(cur); }
#undef PG8_SA
#undef PG8_SB
#undef PG8_STAGE
#undef PG8_LDA
#undef PG8_LDB
#undef PG8_MMA
#undef PG8_WAIT_V
#undef PG8_WAIT_L
#undef PG8_BAR
#undef PG8_SCHED
}
}

using pg8::bf16_t; using pg8::f32x4; using pg8::u32x4; using pg8::bf16x8; using pg8::Unit; using pg8::cvt_pk_bf16;
typedef unsigned u32x2 __attribute__((ext_vector_type(2)));
#define REP0 1
#define REP1 1
#define REP2 1
#define REP3 1
#define REP4 1
#define REP5 1
#define REP7 1
#define REP8 1
#define REPSYNC 0
#ifndef DBG_HI
#define DBG_HI NPHASE
#endif
#ifndef N_LAUNCHES
#define N_LAUNCHES 1
#endif
#ifndef PG8_SP2
#define PG8_SP2 true
#endif
#ifndef PG8_ALIGN
#define PG8_ALIGN true
#endif
constexpr int NPHASE = 9;
constexpr int DM = 1024, MP = 16384, MT = 17408, DIN = 3584, DFF = 2816;
constexpr float EPS = 1e-6f;
constexpr size_t OFF_WIN = 0;
constexpr size_t OFF_WPO = OFF_WIN + 7340032;
constexpr size_t OFF_BPOOL = OFF_WPO + 1048576;
constexpr size_t OFF_WEFF = OFF_BPOOL + 524288;
constexpr size_t OFF_WSO = OFF_WEFF + 1048576;
constexpr size_t OFF_WO = OFF_WSO + 1048576;
constexpr size_t OFF_WUG = OFF_WO + 2097152;
constexpr size_t OFF_WD = OFF_WUG + 11534336;
constexpr size_t OFF_WMP = OFF_WD + 5767168;
constexpr size_t OFF_WMS = OFF_WMP + 131072;
constexpr size_t OFF_SS = OFF_WMS + 131072;
constexpr size_t OFF_R1 = OFF_SS + 1114112;
constexpr size_t OFF_R2 = OFF_R1 + 35651584;
constexpr size_t OFF_Z = OFF_R2, OFF_D = OFF_Z + 124780544, OFF_S = OFF_D + 17825792, OFF_MG = OFF_S + 17825792;
constexpr size_t OFF_A2 = OFF_R2, OFF_G2 = OFF_A2 + 98041856;
constexpr size_t WS_END = OFF_G2 + 98041856;
constexpr size_t OFF_BAR = WS_END;
constexpr size_t BAR_BYTES = 3456 * 4;
constexpr size_t OFF_CNT = OFF_BAR + BAR_BYTES;
constexpr size_t CNT_BYTES = 128 * 256;
constexpr size_t OFF_XS2 = OFF_A2 + 58720256 + 262144;
constexpr size_t OFF_XS = OFF_A2 + 58720256;
constexpr int HALO_OFF = 131072, HALO_BYTES = 4096, ST_OFF = HALO_OFF + HALO_BYTES;
constexpr int LDS_BYTES = ST_OFF + 64;
constexpr size_t OFF_EA = OFF_A2 + 50331648;
constexpr size_t OFF_EG = OFF_EA + 3063808;
static_assert(OFF_MG + 35651584 == WS_END, "region R2 overlay");
constexpr size_t O_Y = 0, O_NPP = 17825792, O_NPS = O_NPP + 61440, O_NCP = O_NPS + 983040, O_NCS = O_NCP + 45056, O_NV = O_NCS + 720896;

struct Params { const float* in[21]; float* out; unsigned char* ws; int ph_lo, ph_hi; };
enum { I_XP = 0, I_XS, I_SPOOL, I_SCONV, I_N1G, I_WIN, I_POOLW, I_PSCALE, I_WPO, I_SNG, I_SGUW, I_SGUB, I_WSO, I_WO, I_N2G, I_WUP, I_WGATE, I_CW, I_CB, I_WDOWN, I_FNG };

__device__ __forceinline__ float bf_lo(unsigned w) { return __uint_as_float(w << 16); }
__device__ __forceinline__ float bf_hi(unsigned w) { return __uint_as_float(w & 0xffff0000u); }
__device__ __forceinline__ unsigned short f2bf(float f) { return (unsigned short)(cvt_pk_bf16(f, 0.f) & 0xffffu); }
__device__ __forceinline__ float gelu_tanh(float x) { const float t = x * (1.f + 0.044715f * x * x); const float e = __builtin_amdgcn_exp2f(-2.3022082f * t); return x * __builtin_amdgcn_rcpf(1.f + e); }
__device__ __forceinline__ float sigm(float x) { return __builtin_amdgcn_rcpf(1.f + __builtin_amdgcn_exp2f(-1.44269504f * x)); }
__device__ __forceinline__ float wave_sum(float v) { v += __shfl_xor(v, 1); v += __shfl_xor(v, 2); v += __shfl_xor(v, 4); v += __shfl_xor(v, 8); v += __shfl_xor(v, 16); v += __shfl_xor(v, 32); return v; }

__device__ __forceinline__ void unpack8(const u32x4 q, f32x4& a, f32x4& b) { a[0] = bf_lo(q.x); a[1] = bf_hi(q.x); a[2] = bf_lo(q.y); a[3] = bf_hi(q.y); b[0] = bf_lo(q.z); b[1] = bf_hi(q.z); b[2] = bf_lo(q.w); b[3] = bf_hi(q.w); }
__device__ __forceinline__ u32x4 pack8(const f32x4 a, const f32x4 b) { u32x4 w; w.x = cvt_pk_bf16(a[0], a[1]); w.y = cvt_pk_bf16(a[2], a[3]); w.z = cvt_pk_bf16(b[0], b[1]); w.w = cvt_pk_bf16(b[2], b[3]); return w; }

struct TJob { const float* src; bf16_t* dst; const float* kscale; int K, N, grp, gstride, off; };
__device__ __forceinline__ void transpose_tile(const TJob& j, int tk, int tn, float* tile) {
    const int tid = threadIdx.x;
#pragma unroll
    for (int p = 0; p < 2; ++p) {
        const int r = (tid >> 4) + p * 32, c4 = (tid & 15) * 4, k = tk * 64 + r;
        const float4 v = *(const float4*)(j.src + (size_t)k * j.N + tn * 64 + c4);
        const float s = j.kscale ? j.kscale[k] : 1.f;
        tile[r * 65 + c4 + 0] = v.x * s; tile[r * 65 + c4 + 1] = v.y * s; tile[r * 65 + c4 + 2] = v.z * s; tile[r * 65 + c4 + 3] = v.w * s;
    }
    __syncthreads();
    const int n = tid >> 3, k8 = (tid & 7) * 8;
    u32x4 w;
    w.x = cvt_pk_bf16(tile[(k8 + 0) * 65 + n], tile[(k8 + 1) * 65 + n]); w.y = cvt_pk_bf16(tile[(k8 + 2) * 65 + n], tile[(k8 + 3) * 65 + n]);
    w.z = cvt_pk_bf16(tile[(k8 + 4) * 65 + n], tile[(k8 + 5) * 65 + n]); w.w = cvt_pk_bf16(tile[(k8 + 6) * 65 + n], tile[(k8 + 7) * 65 + n]);
    const int ng = tn * 64 + n, drow = (ng / j.grp) * j.gstride + (ng % j.grp) + j.off;
    *(u32x4*)(j.dst + (size_t)drow * j.K + tk * 64 + k8) = w;
    __syncthreads();
}
__device__ __forceinline__ void p0_prep(const Params& p, unsigned char* lds) {
    unsigned char* ws = p.ws; const int tid = threadIdx.x, lane = tid & 63, wave = tid >> 6;
    for (int t = blockIdx.x; t < 3520; t += gridDim.x) {
        TJob j; int lt = t;
        if (lt < 896) { j = TJob{p.in[I_WIN], (bf16_t*)(ws + OFF_WIN), nullptr, 1024, 3584, 3584, 0, 0}; }
        else if ((lt -= 896) < 128) { j = TJob{p.in[I_WPO], (bf16_t*)(ws + OFF_WPO), nullptr, 512, 1024, 1024, 0, 0}; }
        else if ((lt -= 128) < 128) { j = TJob{p.in[I_WSO], (bf16_t*)(ws + OFF_WSO), nullptr, 512, 1024, 1024, 0, 0}; }
        else if ((lt -= 128) < 256) { j = TJob{p.in[I_WO], (bf16_t*)(ws + OFF_WO), nullptr, 1024, 1024, 1024, 0, 0}; }
        else if ((lt -= 256) < 704) { j = TJob{p.in[I_WUP], (bf16_t*)(ws + OFF_WUG), p.in[I_N2G], 1024, 2816, 128, 256, 0}; }
        else if ((lt -= 704) < 704) { j = TJob{p.in[I_WGATE], (bf16_t*)(ws + OFF_WUG), p.in[I_N2G], 1024, 2816, 128, 256, 128}; }
        else { lt -= 704; j = TJob{p.in[I_WDOWN], (bf16_t*)(ws + OFF_WD), nullptr, 2816, 1024, 1024, 0, 0}; }
        const int ntn = j.N / 64;
        transpose_tile(j, lt / ntn, lt % ntn, (float*)lds);
    }
    const int gt = blockIdx.x * 512 + tid, gs = gridDim.x * 512;
    { bf16_t* bp = (bf16_t*)(ws + OFF_BPOOL); const float* pw = p.in[I_POOLW]; const float* ps = p.in[I_PSCALE];
      for (int i = gt; i < 512 * 512; i += gs) { const int k = i >> 9, jn = i & 511; float v = 0.f; if ((k >> 7) == (jn >> 7)) v = pw[(k >> 7) * 16384 + (k & 127) * 128 + (jn & 127)] * ps[jn]; bp[i] = f2bf(v); } }
    { bf16_t* wp = (bf16_t*)(ws + OFF_WMP); bf16_t* wsm = (bf16_t*)(ws + OFF_WMS); const float* sw = p.in[I_SGUW];
      for (int i = gt; i < 4 * 128 * 128; i += gs) { const int h = i >> 14, t = (i >> 7) & 127, s = i & 127;
          wp[i] = f2bf(s <= t ? sw[i] : 0.f);
          wsm[i] = f2bf(((t >> 3) == (s >> 3) && (s & 7) <= (t & 7)) ? sw[h * 16384 + (t & 7) * 128 + (s & 7)] : 0.f); } }
    { bf16_t* H = (bf16_t*)(ws + OFF_R1); const float* g1 = p.in[I_N1G];
      for (int rg = blockIdx.x; rg < MT / 8; rg += gridDim.x) {
          const int row = rg * 8 + wave; const float* xr = row < MP ? p.in[I_XP] + (size_t)row * DM : p.in[I_XS] + (size_t)(row - MP) * DM;
          f32x4 v[4]; float ss = 0.f;
#pragma unroll
          for (int i = 0; i < 4; ++i) { v[i] = *(const f32x4*)(xr + i * 256 + lane * 4); ss += v[i][0] * v[i][0] + v[i][1] * v[i][1] + v[i][2] * v[i][2] + v[i][3] * v[i][3]; }
          ss = wave_sum(ss); const float r = rsqrtf(ss * (1.f / 1024.f) + EPS);
#pragma unroll
          for (int i = 0; i < 4; ++i) { const f32x4 g = *(const f32x4*)(g1 + i * 256 + lane * 4); u32x2 w; w.x = cvt_pk_bf16(v[i][0] * r * g[0], v[i][1] * r * g[1]); w.y = cvt_pk_bf16(v[i][2] * r * g[2], v[i][3] * r * g[3]);
              *(u32x2*)(H + (size_t)row * DM + i * 256 + lane * 4) = w; }
      } }
}

template <int ACT> __device__ __forceinline__ void store_bf16_tile(const f32x4 (&acc)[2][2][4][2], bf16_t* O, int ld, int row0, int col0) {
#pragma unroll
    for (int ai = 0; ai < 2; ++ai)
#pragma unroll
        for (int m = 0; m < 4; ++m) { bf16_t* rowp = O + (size_t)(row0 + ai * 128 + m * 16) * ld + col0;
#pragma unroll
            for (int bj = 0; bj < 2; ++bj) { f32x4 v0 = acc[ai][bj][m][0], v1 = acc[ai][bj][m][1];
                if (ACT == 1) {
#pragma unroll
                    for (int j = 0; j < 4; ++j) { v0[j] = gelu_tanh(v0[j]); v1[j] = gelu_tanh(v1[j]); } }
                if (ACT == 2) {
#pragma unroll
                    for (int j = 0; j < 4; ++j) { v0[j] = sigm(v0[j]); v1[j] = sigm(v1[j]); } }
                u32x4 w; w.x = cvt_pk_bf16(v0[0], v0[1]); w.y = cvt_pk_bf16(v0[2], v0[3]); w.z = cvt_pk_bf16(v1[0], v1[1]); w.w = cvt_pk_bf16(v1[2], v1[3]);
                *(u32x4*)(rowp + bj * 128) = w; } }
}
struct EpiPlain { static constexpr bool PERM = true, AFTER_DRAIN = false; bf16_t* O; int ld;
    __device__ __forceinline__ void operator()(const f32x4 (&acc)[2][2][4][2], const Unit& u, int wr, int wc, int fr, int fq) const {
        store_bf16_tile<0>(acc, O, ld, u.pm * 256 + wr * 64 + fr, u.pn * 256 + wc * 32 + 8 * fq); } };
struct EpiZ { static constexpr bool PERM = true, AFTER_DRAIN = false; bf16_t* Z; float* SSV;
    __device__ __forceinline__ void operator()(const f32x4 (&acc)[2][2][4][2], const Unit& u, int wr, int wc, int fr, int fq) const {
        const int row0 = u.pm * 256 + wr * 64 + fr, col0 = u.pn * 256 + wc * 32 + 8 * fq;
        if (u.pn < 2) store_bf16_tile<0>(acc, Z, DIN, row0, col0);
        else if (u.pn < 4) store_bf16_tile<1>(acc, Z, DIN, row0, col0);
        else if (u.pn < 6) {
#pragma unroll
            for (int ai = 0; ai < 2; ++ai)
#pragma unroll
                for (int m = 0; m < 4; ++m) { const size_t row = (size_t)(row0 + ai * 128 + m * 16); bf16_t* rowp = Z + row * DIN + col0; float ss = 0.f;
#pragma unroll
                    for (int bj = 0; bj < 2; ++bj) { f32x4 v0 = acc[ai][bj][m][0], v1 = acc[ai][bj][m][1];
#pragma unroll
                        for (int j = 0; j < 4; ++j) { v0[j] = gelu_tanh(v0[j]); v1[j] = gelu_tanh(v1[j]); ss += v0[j] * v0[j] + v1[j] * v1[j]; }
                        *(u32x4*)(rowp + bj * 128) = pack8(v0, v1); }
                    ss += __shfl_xor(ss, 16); ss += __shfl_xor(ss, 32);
                    if (fq == 0) SSV[row * 8 + (u.pn - 4) * 4 + wc] = ss; }
        }
        else store_bf16_tile<2>(acc, Z, DIN, row0, col0); } };
template <int MODE> struct EpiGate { static constexpr bool PERM = true, AFTER_DRAIN = false; const bf16_t* Z; bf16_t* MG; int goff;
    __device__ __forceinline__ void operator()(const f32x4 (&acc)[2][2][4][2], const Unit& u, int wr, int wc, int fr, int fq) const {
        const int row0 = u.pm * 256 + wr * 64 + fr, col0 = u.pn * 256 + wc * 32 + 8 * fq;
#pragma unroll
        for (int ai = 0; ai < 2; ++ai)
#pragma unroll
            for (int m = 0; m < 4; ++m) { const size_t row = (size_t)(row0 + ai * 128 + m * 16);
#pragma unroll
                for (int bj = 0; bj < 2; ++bj) { const int col = col0 + bj * 128;
                    const u32x4 g = *(const u32x4*)(Z + row * DIN + goff + col);
                    f32x4 v0 = acc[ai][bj][m][0], v1 = acc[ai][bj][m][1];
                    v0[0] *= bf_lo(g.x); v0[1] *= bf_hi(g.x); v0[2] *= bf_lo(g.y); v0[3] *= bf_hi(g.y);
                    v1[0] *= bf_lo(g.z); v1[1] *= bf_hi(g.z); v1[2] *= bf_lo(g.w); v1[3] *= bf_hi(g.w);
                    if (MODE == 1) { const u32x4 o = *(const u32x4*)(MG + row * DM + col);
                        v0[0] += bf_lo(o.x); v0[1] += bf_hi(o.x); v0[2] += bf_lo(o.y); v0[3] += bf_hi(o.y);
                        v1[0] += bf_lo(o.z); v1[1] += bf_hi(o.z); v1[2] += bf_lo(o.w); v1[3] += bf_hi(o.w); }
                    u32x4 w; w.x = cvt_pk_bf16(v0[0], v0[1]); w.y = cvt_pk_bf16(v0[2], v0[3]); w.z = cvt_pk_bf16(v1[0], v1[1]); w.w = cvt_pk_bf16(v1[2], v1[3]);
                    *(u32x4*)(MG + row * DM + col) = w; }
                asm volatile("" ::: "memory"); }
    } };
template <int MODE> struct EpiRes { static constexpr bool PERM = true, AFTER_DRAIN = false; const float* xp; const float* xs; float* Y; bf16_t* Xb; float* SS; float* Yout;
    __device__ __forceinline__ void operator()(const f32x4 (&acc)[2][2][4][2], const Unit& u, int wr, int wc, int fr, int fq) const {
        const int row0 = u.pm * 256 + wr * 64 + fr, col0 = u.pn * 256 + wc * 32 + 8 * fq;
        const float* base = MODE == 1 ? (const float*)Y : (u.pm < 64 ? xp : xs - (size_t)MP * DM);
#pragma unroll
        for (int ai = 0; ai < 2; ++ai)
#pragma unroll
            for (int m = 0; m < 4; ++m) { const size_t row = (size_t)(row0 + ai * 128 + m * 16); float ss = 0.f;
#pragma unroll
                for (int bj = 0; bj < 2; ++bj) { const size_t o = row * DM + col0 + bj * 128;
                    const f32x4 v0 = *(const f32x4*)(base + o) + acc[ai][bj][m][0], v1 = *(const f32x4*)(base + o + 4) + acc[ai][bj][m][1];
                    *(f32x4*)(Yout + o) = v0; *(f32x4*)(Yout + o + 4) = v1;
                    ss += (v0[0] * v0[0] + v0[1] * v0[1]) + (v0[2] * v0[2] + v0[3] * v0[3]) + (v1[0] * v1[0] + v1[1] * v1[1]) + (v1[2] * v1[2] + v1[3] * v1[3]);
                    if (MODE == 0) *(u32x4*)(Xb + o) = pack8(v0, v1); }
                ss += __shfl_xor(ss, 16); ss += __shfl_xor(ss, 32);
                if (MODE == 0 && fq == 0) SS[row * 16 + u.pn * 4 + wc] = ss;
                asm volatile("" ::: "memory"); }
    } };
struct EpiDownNorm { static constexpr bool PERM = true, AFTER_DRAIN = true; float* Y; const float* gf; float* XS; unsigned* cnt;
    __device__ __forceinline__ void operator()(const f32x4 (&)[2][2][4][2], const Unit&, int, int, int, int) const {}
    __device__ __forceinline__ void fused(const f32x4 (&acc)[2][2][4][2], const Unit& u, int wr, int wc, int fr, int fq, PG8_LAS unsigned char* lds, int wid, int lane) const {
        PG8_LAS float* P = (PG8_LAS float*)lds; PG8_LAS float* R = (PG8_LAS float*)(lds + 4096);
        const int row0 = u.pm * 256 + wr * 64 + fr, col0 = u.pn * 256 + wc * 32 + 8 * fq;
        f32x4 v[2][2][4][2];
#pragma unroll
        for (int ai = 0; ai < 2; ++ai)
#pragma unroll
            for (int m = 0; m < 4; ++m) { const size_t row = (size_t)(row0 + ai * 128 + m * 16); float ss = 0.f;
#pragma unroll
                for (int bj = 0; bj < 2; ++bj) { const size_t o = row * DM + col0 + bj * 128;
                    const f32x4 v0 = *(const f32x4*)(Y + o) + acc[ai][bj][m][0], v1 = *(const f32x4*)(Y + o + 4) + acc[ai][bj][m][1];
                    v[ai][bj][m][0] = v0; v[ai][bj][m][1] = v1;
                    ss += (v0[0] * v0[0] + v0[1] * v0[1]) + (v0[2] * v0[2] + v0[3] * v0[3]) + (v1[0] * v1[0] + v1[1] * v1[1]) + (v1[2] * v1[2] + v1[3] * v1[3]); }
                ss += __shfl_xor(ss, 16); ss += __shfl_xor(ss, 32);
                if (fq == 0) P[(ai * 128 + wr * 64 + m * 16 + fr) * 4 + wc] = ss;
                if (m == 3) asm volatile("" ::: "memory"); }
        asm volatile("s_waitcnt lgkmcnt(0)" ::: "memory"); __builtin_amdgcn_s_barrier(); asm volatile("" ::: "memory");
        const int r = wid * 32 + (lane & 31);
        if (lane < 32) { const f32x4 q = *(const PG8_LAS f32x4*)(P + r * 4);
            __hip_atomic_store(XS + ((size_t)u.pm * 256 + r) * 4 + u.pn, (q[0] + q[1]) + (q[2] + q[3]), __ATOMIC_RELAXED, __HIP_MEMORY_SCOPE_AGENT); }
        asm volatile("s_waitcnt vmcnt(0)" ::: "memory");
        if (lane == 0) __hip_atomic_fetch_add(cnt + 64 * u.pm, 1u, __ATOMIC_RELAXED, __HIP_MEMORY_SCOPE_AGENT);
        if (wid == 0) { unsigned sp = 0u;
            while ((unsigned)__builtin_amdgcn_readfirstlane(__hip_atomic_load(cnt + 64 * u.pm, __ATOMIC_RELAXED, __HIP_MEMORY_SCOPE_AGENT)) < 32u && ++sp < (1u << 20)) __builtin_amdgcn_s_sleep(2);
            __builtin_amdgcn_fence(__ATOMIC_ACQUIRE, "agent"); asm volatile("s_waitcnt vmcnt(0)" ::: "memory"); }
        asm volatile("" ::: "memory"); __builtin_amdgcn_s_barrier(); asm volatile("" ::: "memory");
        if (lane < 32) { const float* xp = XS + ((size_t)u.pm * 256 + r) * 4;
            const float s4 = (__hip_atomic_load(xp, __ATOMIC_RELAXED, __HIP_MEMORY_SCOPE_AGENT) + __hip_atomic_load(xp + 1, __ATOMIC_RELAXED, __HIP_MEMORY_SCOPE_AGENT))
                           + (__hip_atomic_load(xp + 2, __ATOMIC_RELAXED, __HIP_MEMORY_SCOPE_AGENT) + __hip_atomic_load(xp + 3, __ATOMIC_RELAXED, __HIP_MEMORY_SCOPE_AGENT));
            R[r] = rsqrtf(s4 * (1.f / 1024.f) + EPS); }
        asm volatile("s_waitcnt lgkmcnt(0)" ::: "memory"); __builtin_amdgcn_s_barrier(); asm volatile("" ::: "memory");
        const f32x4 g00 = *(const f32x4*)(gf + col0), g01 = *(const f32x4*)(gf + col0 + 4), g10 = *(const f32x4*)(gf + col0 + 128), g11 = *(const f32x4*)(gf + col0 + 132);
#pragma unroll
        for (int ai = 0; ai < 2; ++ai)
#pragma unroll
            for (int m = 0; m < 4; ++m) { const int rl = ai * 128 + wr * 64 + m * 16 + fr; const float rr = R[rl]; float* yp = Y + (size_t)(u.pm * 256 + rl) * DM + col0;
                *(f32x4*)yp = v[ai][0][m][0] * rr * g00; *(f32x4*)(yp + 4) = v[ai][0][m][1] * rr * g01; *(f32x4*)(yp + 128) = v[ai][1][m][0] * rr * g10; *(f32x4*)(yp + 132) = v[ai][1][m][1] * rr * g11; }
    } };
struct EpiWoNorm { static constexpr bool PERM = true, AFTER_DRAIN = true; const float* xp; float* Y; bf16_t* Xb; float* XS; unsigned* cnt;
    __device__ __forceinline__ void operator()(const f32x4 (&)[2][2][4][2], const Unit&, int, int, int, int) const {}
    __device__ __forceinline__ void fused(const f32x4 (&acc)[2][2][4][2], const Unit& u, int wr, int wc, int fr, int fq, PG8_LAS unsigned char* lds, int wid, int lane) const {
        PG8_LAS float* P = (PG8_LAS float*)lds; PG8_LAS float* R = (PG8_LAS float*)(lds + 4096);
        const int row0 = u.pm * 256 + wr * 64 + fr, col0 = u.pn * 256 + wc * 32 + 8 * fq;
        f32x4 v[2][2][4][2];
#pragma unroll
        for (int ai = 0; ai < 2; ++ai)
#pragma unroll
            for (int m = 0; m < 4; ++m) { const size_t row = (size_t)(row0 + ai * 128 + m * 16); float ss = 0.f;
#pragma unroll
                for (int bj = 0; bj < 2; ++bj) { const size_t o = row * DM + col0 + bj * 128;
                    const f32x4 v0 = *(const f32x4*)(xp + o) + acc[ai][bj][m][0], v1 = *(const f32x4*)(xp + o + 4) + acc[ai][bj][m][1];
                    *(f32x4*)(Y + o) = v0; *(f32x4*)(Y + o + 4) = v1; v[ai][bj][m][0] = v0; v[ai][bj][m][1] = v1;
                    ss += (v0[0] * v0[0] + v0[1] * v0[1]) + (v0[2] * v0[2] + v0[3] * v0[3]) + (v1[0] * v1[0] + v1[1] * v1[1]) + (v1[2] * v1[2] + v1[3] * v1[3]); }
                ss += __shfl_xor(ss, 16); ss += __shfl_xor(ss, 32);
                if (fq == 0) P[(ai * 128 + wr * 64 + m * 16 + fr) * 4 + wc] = ss;
                if (m == 3) asm volatile("" ::: "memory"); }
        asm volatile("s_waitcnt lgkmcnt(0)" ::: "memory"); __builtin_amdgcn_s_barrier(); asm volatile("" ::: "memory");
        const int r = wid * 32 + (lane & 31);
        if (lane < 32) { const f32x4 q = *(const PG8_LAS f32x4*)(P + r * 4);
            __hip_atomic_store(XS + ((size_t)u.pm * 256 + r) * 4 + u.pn, (q[0] + q[1]) + (q[2] + q[3]), __ATOMIC_RELAXED, __HIP_MEMORY_SCOPE_AGENT); }
        asm volatile("s_waitcnt vmcnt(0)" ::: "memory");
        if (lane == 0) __hip_atomic_fetch_add(cnt + 64 * u.pm, 1u, __ATOMIC_RELAXED, __HIP_MEMORY_SCOPE_AGENT);
        if (wid == 0) { unsigned sp = 0u;
            while ((unsigned)__builtin_amdgcn_readfirstlane(__hip_atomic_load(cnt + 64 * u.pm, __ATOMIC_RELAXED, __HIP_MEMORY_SCOPE_AGENT)) < 32u && ++sp < (1u << 20)) __builtin_amdgcn_s_sleep(2);
            __builtin_amdgcn_fence(__ATOMIC_ACQUIRE, "agent"); asm volatile("s_waitcnt vmcnt(0)" ::: "memory"); }
        asm volatile("" ::: "memory"); __builtin_amdgcn_s_barrier(); asm volatile("" ::: "memory");
        if (lane < 32) { const float* xq = XS + ((size_t)u.pm * 256 + r) * 4;
            const float s4 = (__hip_atomic_load(xq, __ATOMIC_RELAXED, __HIP_MEMORY_SCOPE_AGENT) + __hip_atomic_load(xq + 1, __ATOMIC_RELAXED, __HIP_MEMORY_SCOPE_AGENT))
                           + (__hip_atomic_load(xq + 2, __ATOMIC_RELAXED, __HIP_MEMORY_SCOPE_AGENT) + __hip_atomic_load(xq + 3, __ATOMIC_RELAXED, __HIP_MEMORY_SCOPE_AGENT));
            R[r] = rsqrtf(s4 * (1.f / 1024.f) + EPS); }
        asm volatile("s_waitcnt lgkmcnt(0)" ::: "memory"); __builtin_amdgcn_s_barrier(); asm volatile("" ::: "memory");
#pragma unroll
        for (int ai = 0; ai < 2; ++ai)
#pragma unroll
            for (int m = 0; m < 4; ++m) { const int rl = ai * 128 + wr * 64 + m * 16 + fr; const float rr = R[rl]; bf16_t* bp = Xb + (size_t)(u.pm * 256 + rl) * DM + col0;
                *(u32x4*)bp = pack8(v[ai][0][m][0] * rr, v[ai][0][m][1] * rr); *(u32x4*)(bp + 128) = pack8(v[ai][1][m][0] * rr, v[ai][1][m][1] * rr); }
    } };
struct EpiPartial { static constexpr bool PERM = true, AFTER_DRAIN = false; float* P; int kext;
    __device__ __forceinline__ void operator()(const f32x4 (&acc)[2][2][4][2], const Unit& u, int wr, int wc, int fr, int fq) const {
        const int row0 = u.pm * 256 + wr * 64 + fr, col0 = u.pn * 256 + wc * 32 + 8 * fq; float* base = P + (size_t)(u.ko / kext) * ((size_t)(MT - MP) * DM);
#pragma unroll
        for (int ai = 0; ai < 2; ++ai)
#pragma unroll
            for (int m = 0; m < 4; ++m) { float* rowp = base + (size_t)(row0 + ai * 128 + m * 16) * DM + col0;
#pragma unroll
                for (int bj = 0; bj < 2; ++bj) { *(f32x4*)(rowp + bj * 128) = acc[ai][bj][m][0]; *(f32x4*)(rowp + bj * 128 + 4) = acc[ai][bj][m][1]; } }
    } };
struct EpiUG { static constexpr bool PERM = true, AFTER_DRAIN = false; const float* SS; bf16_t* A2; bf16_t* G2;
    __device__ __forceinline__ void operator()(const f32x4 (&acc)[2][2][4][2], const Unit& u, int wr, int wc, int fr, int fq) const {
        const int row0 = u.pm * 256 + wr * 64 + fr, ch0 = u.pn * 128 + wc * 32 + 8 * fq;
#pragma unroll
        for (int ai = 0; ai < 2; ++ai)
#pragma unroll
            for (int m = 0; m < 4; ++m) { const size_t row = (size_t)(row0 + ai * 128 + m * 16);
                const f32x4 s0 = *(const f32x4*)(SS + row * 16), s1 = *(const f32x4*)(SS + row * 16 + 4), s2 = *(const f32x4*)(SS + row * 16 + 8), s3 = *(const f32x4*)(SS + row * 16 + 12);
                const f32x4 st = (s0 + s1) + (s2 + s3); const float r = rsqrtf(((st[0] + st[1]) + (st[2] + st[3])) * (1.f / 1024.f) + EPS);
#pragma unroll
                for (int bj = 0; bj < 2; ++bj) { const f32x4 v0 = acc[ai][bj][m][0] * r, v1 = acc[ai][bj][m][1] * r;
                    u32x4 w; w.x = cvt_pk_bf16(v0[0], v0[1]); w.y = cvt_pk_bf16(v0[2], v0[3]); w.z = cvt_pk_bf16(v1[0], v1[1]); w.w = cvt_pk_bf16(v1[2], v1[3]);
                    *(u32x4*)((bj ? G2 : A2) + row * DFF + ch0) = w; }
                asm volatile("" ::: "memory"); }
    } };


__device__ __forceinline__ float rms_of(const float* SS, int row) { const float* sp = SS + (size_t)row * 16;
    const f32x4 st = (*(const f32x4*)sp + *(const f32x4*)(sp + 4)) + (*(const f32x4*)(sp + 8) + *(const f32x4*)(sp + 12)); return rsqrtf(((st[0] + st[1]) + (st[2] + st[3])) * (1.f / 1024.f) + EPS); }
template <int CTRL> __device__ __forceinline__ float dpp_f(float v) { const int x = __builtin_bit_cast(int, v); return __builtin_bit_cast(float, __builtin_amdgcn_update_dpp(x, x, CTRL, 0xf, 0xf, false)); }
struct EpiUGConv { static constexpr bool PERM = true, AFTER_DRAIN = false;
    const float* SS; bf16_t* F; float* EA; float* EG; const float* cw; const float* cb; const float* sc; float* out; PG8_LAS float* halo; int prenorm;
    __device__ __forceinline__ void operator()(const f32x4 (&acc)[2][2][4][2], const Unit& u, int wr, int wc, int fr, int fq) const {
        const int ch0 = u.pn * 128 + wc * 32 + 8 * fq, rowt = u.pm * 256 + wr * 64 + fr; const bool smp = u.pm >= 64;
        const f32x4 w0a = *(const f32x4*)(cw + ch0), w0b = *(const f32x4*)(cw + ch0 + 4), w1a = *(const f32x4*)(cw + DFF + ch0), w1b = *(const f32x4*)(cw + DFF + ch0 + 4);
        const f32x4 w2a = *(const f32x4*)(cw + 2 * DFF + ch0), w2b = *(const f32x4*)(cw + 2 * DFF + ch0 + 4), ba = *(const f32x4*)(cb + ch0), bb = *(const f32x4*)(cb + ch0 + 4);
        const f32x4 z4 = (f32x4){0.f, 0.f, 0.f, 0.f};
        if (!smp) {
            if (fr >= 14) {
#pragma unroll
                for (int ai = 0; ai < 2; ++ai) { const float r3 = prenorm ? 1.f : rms_of(SS, rowt + ai * 128 + 48);
                    PG8_LAS float* hp = halo + (((2 * ai + wr) * 4 + wc) * 2 + (fr - 14)) * 32 + fq * 8;
                    *(PG8_LAS f32x4*)hp = acc[ai][0][3][0] * r3; *(PG8_LAS f32x4*)(hp + 4) = acc[ai][0][3][1] * r3; } }
            asm volatile("s_waitcnt lgkmcnt(0)" ::: "memory"); __builtin_amdgcn_s_barrier(); asm volatile("" ::: "memory"); __builtin_amdgcn_s_barrier(); asm volatile("" ::: "memory");
        }
#pragma unroll
        for (int ai = 0; ai < 2; ++ai) { float rprev = 0.f;
#pragma unroll
            for (int m = 0; m < 4; ++m) {
                const int rowi = rowt + ai * 128 + m * 16; const size_t row = (size_t)rowi; const float rc = (prenorm && !smp) ? 1.f : rms_of(SS, rowi);
                const f32x4 ca = acc[ai][0][m][0] * rc, cbv = acc[ai][0][m][1] * rc, ga = acc[ai][1][m][0] * rc, gb = acc[ai][1][m][1] * rc;
                f32x4 pa = z4, pb = z4;
                if (m > 0) { pa = acc[ai][0][m > 0 ? m - 1 : 0][0] * rprev; pb = acc[ai][0][m > 0 ? m - 1 : 0][1] * rprev; }
                else if (!smp && 2 * ai + wr >= 1) { const PG8_LAS float* hp = halo + ((((2 * ai + wr - 1) * 4 + wc) * 2 + (fr == 15 ? 1 : 0)) * 32) + fq * 8; pa = *(const PG8_LAS f32x4*)hp; pb = *(const PG8_LAS f32x4*)(hp + 4); }
                rprev = rc;
                f32x4 p1a, p1b, p2a, p2b;
#pragma unroll
                for (int k = 0; k < 4; ++k) {
                    p1a[k] = dpp_f<0x121>(fr == 15 ? pa[k] : ca[k]); p1b[k] = dpp_f<0x121>(fr == 15 ? pb[k] : cbv[k]);
                    p2a[k] = dpp_f<0x122>(fr >= 14 ? pa[k] : ca[k]); p2b[k] = dpp_f<0x122>(fr >= 14 ? pb[k] : cbv[k]); }
                if (smp) { const int t = fr & 7, db = (rowi - MP) >> 3;
                    if (t < 2) { const float* s0 = sc + (size_t)db * 2 * DFF + ch0; const f32x4 s0a = *(const f32x4*)s0, s0b = *(const f32x4*)(s0 + 4), s1a = *(const f32x4*)(s0 + DFF), s1b = *(const f32x4*)(s0 + DFF + 4);
                        if (t == 0) { p1a = s1a; p1b = s1b; p2a = s0a; p2b = s0b; } else { p2a = s1a; p2b = s1b; } }
                    if (t >= 6) { float* q = out + O_NCS + ((size_t)db * 2 + (t - 6)) * DFF + ch0; *(f32x4*)q = ca; *(f32x4*)(q + 4) = cbv; } }
                else {
                    if (ai == 0 && m == 0 && wr == 0 && fr < 2) { float* q = EA + ((size_t)u.pm * 4 + fr) * DFF + ch0; *(f32x4*)q = ca; *(f32x4*)(q + 4) = cbv; float* q2 = EG + ((size_t)u.pm * 2 + fr) * DFF + ch0; *(f32x4*)q2 = ga; *(f32x4*)(q2 + 4) = gb; }
                    if (ai == 1 && m == 3 && wr == 1 && fr >= 14) { float* q = EA + ((size_t)u.pm * 4 + 2 + (fr - 14)) * DFF + ch0; *(f32x4*)q = ca; *(f32x4*)(q + 4) = cbv;
                        if ((u.pm & 7) == 7) { float* q2 = out + O_NCP + ((size_t)(u.pm >> 3) * 2 + (fr - 14)) * DFF + ch0; *(f32x4*)q2 = ca; *(f32x4*)(q2 + 4) = cbv; } } }
                const f32x4 xa = w0a * p2a + w1a * p1a + w2a * ca + ba, xb = w0b * p2b + w1b * p1b + w2b * cbv + bb;
                f32x4 fa, fb;
#pragma unroll
                for (int k = 0; k < 4; ++k) { fa[k] = gelu_tanh(xa[k]) * ga[k]; fb[k] = gelu_tanh(xb[k]) * gb[k]; }
                *(u32x4*)(F + row * DFF + ch0) = pack8(fa, fb);
                if (m == 3) asm volatile("" ::: "memory"); } }
    } };
__device__ __forceinline__ void p6_fix(const Params& p, int pm) {
    const float* EA = (const float*)(p.ws + OFF_EA); const float* EG = (const float*)(p.ws + OFF_EG); bf16_t* F = (bf16_t*)(p.ws + OFF_G2); const float* cw = p.in[I_CW]; const float* cb = p.in[I_CB];
    for (int it = threadIdx.x; it < 704; it += 512) { const int r01 = it >= 352 ? 1 : 0, ch = (it - r01 * 352) * 8;
        const float* e2 = EA + ((size_t)(pm - 1) * 4 + 2 + r01) * DFF + ch;
        const float* e1 = r01 ? EA + ((size_t)pm * 4 + 0) * DFF + ch : EA + ((size_t)(pm - 1) * 4 + 3) * DFF + ch;
        const float* e0 = EA + ((size_t)pm * 4 + r01) * DFF + ch; const float* gg = EG + ((size_t)pm * 2 + r01) * DFF + ch;
        f32x4 fa, fb;
#pragma unroll
        for (int hf = 0; hf < 2; ++hf) { const int o = hf * 4; const f32x4 x = *(const f32x4*)(cw + ch + o) * *(const f32x4*)(e2 + o) + *(const f32x4*)(cw + DFF + ch + o) * *(const f32x4*)(e1 + o) + *(const f32x4*)(cw + 2 * DFF + ch + o) * *(const f32x4*)(e0 + o) + *(const f32x4*)(cb + ch + o);
            const f32x4 g = *(const f32x4*)(gg + o); f32x4 f;
#pragma unroll
            for (int k = 0; k < 4; ++k) f[k] = gelu_tanh(x[k]) * g[k];
            if (hf) fb = f; else fa = f; }
        *(u32x4*)(F + ((size_t)pm * 256 + r01) * DFF + ch) = pack8(fa, fb); }
    asm volatile("s_waitcnt vmcnt(0)" ::: "memory"); __syncthreads();
}


__device__ __forceinline__ void small_mma(const bf16_t* A, int lda, const bf16_t* Bt, int ldb, int K, int arow, int bcol, int fq, f32x4 (&acc)[2]) {
    const bf16_t* ap = A + (size_t)arow * lda + fq * 8; const bf16_t* b0 = Bt + (size_t)bcol * ldb + fq * 8; const bf16_t* b1 = b0 + (size_t)16 * ldb;
    for (int k0 = 0; k0 < K; k0 += 256) {
        bf16x8 a[8], x[8], y[8];
#pragma unroll
        for (int u = 0; u < 8; ++u) { a[u] = *(const bf16x8*)(ap + k0 + u * 32); x[u] = *(const bf16x8*)(b0 + k0 + u * 32); y[u] = *(const bf16x8*)(b1 + k0 + u * 32); }
#pragma unroll
        for (int u = 0; u < 8; ++u) { acc[0] = __builtin_amdgcn_mfma_f32_16x16x32_bf16(x[u], a[u], acc[0], 0, 0, 0); acc[1] = __builtin_amdgcn_mfma_f32_16x16x32_bf16(y[u], a[u], acc[1], 0, 0, 0); }
    }
}
__device__ __forceinline__ void small_ab(const Params& p) {
    unsigned char* ws = p.ws; const int tid = threadIdx.x, lane = tid & 63, w = tid >> 6, fr = lane & 15, fq = lane >> 4;
    const bf16_t* Z = (const bf16_t*)(ws + OFF_Z); bf16_t* MG = (bf16_t*)(ws + OFF_MG);
    for (int t = blockIdx.x; t < 256; t += gridDim.x) { const int tm = t >> 4, tn = t & 15, arow = MP + tm * 64 + (w & 3) * 16 + fr, cb = tn * 64 + (w >> 2) * 32;
        f32x4 aa[2] = {(f32x4){0.f, 0.f, 0.f, 0.f}, (f32x4){0.f, 0.f, 0.f, 0.f}}, ab[2] = {(f32x4){0.f, 0.f, 0.f, 0.f}, (f32x4){0.f, 0.f, 0.f, 0.f}};
        small_mma((const bf16_t*)(ws + OFF_D), 512, (const bf16_t*)(ws + OFF_WEFF), 512, 512, arow, cb + fr, fq, aa);
        small_mma((const bf16_t*)(ws + OFF_S), 512, (const bf16_t*)(ws + OFF_WSO), 512, 512, arow, cb + fr, fq, ab);
#pragma unroll
        for (int t2 = 0; t2 < 2; ++t2) { const int col = cb + t2 * 16 + fq * 4; const u32x2 ga = *(const u32x2*)(Z + (size_t)arow * DIN + 1536 + col), gb = *(const u32x2*)(Z + (size_t)arow * DIN + 2560 + col);
            u32x2 o; o.x = cvt_pk_bf16(bf_lo(ga.x) * aa[t2][0] + bf_lo(gb.x) * ab[t2][0], bf_hi(ga.x) * aa[t2][1] + bf_hi(gb.x) * ab[t2][1]);
            o.y = cvt_pk_bf16(bf_lo(ga.y) * aa[t2][2] + bf_lo(gb.y) * ab[t2][2], bf_hi(ga.y) * aa[t2][3] + bf_hi(gb.y) * ab[t2][3]);
            *(u32x2*)(MG + (size_t)arow * DM + col) = o; } }
}
__device__ __forceinline__ void small_o(const Params& p, unsigned char* lds) {
    unsigned char* ws = p.ws; const int tid = threadIdx.x, lane = tid & 63, w = tid >> 6, fr = lane & 15, fq = lane >> 4;
    float* Y = p.out + O_Y; bf16_t* Xb = (bf16_t*)(ws + OFF_R1); float* SS = (float*)(ws + OFF_SS); float* red = (float*)lds; const float* xs = p.in[I_XS];
    for (int t = blockIdx.x; t < 256; t += gridDim.x) { const int tm = t >> 4, tn = t & 15, arow = MP + tm * 64 + (w & 3) * 16 + fr, cb = tn * 64 + (w >> 2) * 32;
        f32x4 acc[2] = {(f32x4){0.f, 0.f, 0.f, 0.f}, (f32x4){0.f, 0.f, 0.f, 0.f}};
        small_mma((const bf16_t*)(ws + OFF_MG), 1024, (const bf16_t*)(ws + OFF_WO), 1024, 1024, arow, cb + fr, fq, acc);
        float ss = 0.f;
#pragma unroll
        for (int t2 = 0; t2 < 2; ++t2) { const int col = cb + t2 * 16 + fq * 4; const f32x4 v = *(const f32x4*)(xs + (size_t)(arow - MP) * DM + col) + acc[t2];
            *(f32x4*)(Y + (size_t)arow * DM + col) = v; ss += (v[0] * v[0] + v[1] * v[1]) + (v[2] * v[2] + v[3] * v[3]);
            u32x2 o; o.x = cvt_pk_bf16(v[0], v[1]); o.y = cvt_pk_bf16(v[2], v[3]); *(u32x2*)(Xb + (size_t)arow * DM + col) = o; }
        ss += __shfl_xor(ss, 16); ss += __shfl_xor(ss, 32);
        if (fq == 0) red[w * 16 + fr] = ss;
        __syncthreads();
        if (w < 4 && fq == 0) SS[(size_t)arow * 16 + tn] = red[w * 16 + fr] + red[(w + 4) * 16 + fr];
        __syncthreads(); }
}

template <int W> __device__ __forceinline__ void pool_wave(const Params& p, int rq, int h, int lane) {
    const bf16_t* Z = (const bf16_t*)(p.ws + OFF_Z); bf16_t* Dd = (bf16_t*)(p.ws + OFF_D); const float* spool = p.in[I_SPOOL]; float* out = p.out;
    const int run = lane >> 4, cgi = lane & 15, row0 = rq * 32 + run * 8, c0 = h * 128 + cgi * 8;
    const bool smp = row0 >= MP; const int pos0 = row0 & 2047, db = (row0 - MP) >> 3;
    u32x4 ext[W - 1 + 8];
#pragma unroll
    for (int i = 0; i < 8; ++i) ext[W - 1 + i] = *(const u32x4*)(Z + (size_t)(row0 + i) * DIN + c0);
    if (!smp) {
#pragma unroll
        for (int k = 1; k < W; ++k) { const bool ok = pos0 - k >= 0; const u32x4 q = *(const u32x4*)(Z + (size_t)(ok ? row0 - k : row0) * DIN + c0); ext[W - 1 - k] = ok ? q : (u32x4){0u, 0u, 0u, 0u}; }
    } else {
#pragma unroll
        for (int k = 1; k < W; ++k) { const float* sp = spool + ((size_t)db * 15 + 15 - k) * 512 + c0; ext[W - 1 - k] = pack8(*(const f32x4*)sp, *(const f32x4*)(sp + 4)); }
    }
    f32x4 s0 = (f32x4){0.f, 0.f, 0.f, 0.f}, s1 = s0;
#pragma unroll
    for (int j = 0; j < W; ++j) { f32x4 a, b; unpack8(ext[j], a, b); s0 += a; s1 += b; }
#pragma unroll
    for (int i = 0; i < 8; ++i) {
        f32x4 ca, cb; unpack8(ext[W - 1 + i], ca, cb);
        const int t = pos0 + i; const int cnt = smp ? W : (W < t + 1 ? W : t + 1); const float inv = 1.f / (float)cnt;
        *(u32x4*)(Dd + (size_t)(row0 + i) * 512 + c0) = pack8(s0 * inv - ca, s1 * inv - cb);
        if (smp) { float* o = out + O_NPS + ((size_t)db * 15 + 7 + i) * 512 + c0; *(f32x4*)o = ca; *(f32x4*)(o + 4) = cb; }
        else if (t >= 2033) { float* o = out + O_NPP + ((size_t)(row0 >> 11) * 15 + (t - 2033)) * 512 + c0; *(f32x4*)o = ca; *(f32x4*)(o + 4) = cb; }
        if (i < 7) { f32x4 na, nb, oa, ob; unpack8(ext[W + i], na, nb); unpack8(ext[i], oa, ob); s0 += na - oa; s1 += nb - ob; }
    }
    if (smp && h == 0) {
#pragma unroll
        for (int j = 0; j < 7; ++j)
#pragma unroll
            for (int g = 0; g < 4; ++g) { const float* sp = spool + ((size_t)db * 15 + 8 + j) * 512 + g * 128 + cgi * 8; float* o = out + O_NPS + ((size_t)db * 15 + j) * 512 + g * 128 + cgi * 8;
                *(f32x4*)o = *(const f32x4*)sp; *(f32x4*)(o + 4) = *(const f32x4*)(sp + 4); }
    }
}
__device__ __forceinline__ void p2_mixer(const Params& p, unsigned char* lds) {
    unsigned char* ws = p.ws; const int tid = threadIdx.x, lane = tid & 63, wave = tid >> 6, fr = lane & 15, fq = lane >> 4;
    const bf16_t* Z = (const bf16_t*)(ws + OFF_Z); bf16_t* Sd = (bf16_t*)(ws + OFF_S); const float* SSV = (const float*)(ws + OFF_SS);
    bf16_t* Vt = (bf16_t*)lds; float* rs = (float*)(lds + 34816);
    const float* sng = p.in[I_SNG]; const float* sgub = p.in[I_SGUB];
    float* out = p.out;
    for (int wi = ((int)gridDim.x - 1 - (int)blockIdx.x) * 8 + wave; wi < (MT / 32) * 4; wi += gridDim.x * 8) { const int h = wi & 3, rq = wi >> 2;
        if (h == 0) pool_wave<2>(p, rq, 0, lane); else if (h == 1) pool_wave<4>(p, rq, 1, lane); else if (h == 2) pool_wave<8>(p, rq, 2, lane); else pool_wave<16>(p, rq, 3, lane); }
    { const int sp = tid >> 3, dq = tid & 7, d0 = dq * 16, tl = 16 * wave + fr;
      u32x4 q00, q01, q10, q11; u32x2 uu[8], un[8]; float bias = 0.f, biasn = 0.f; int par = 0;
#define SGU_LOAD(IT, UU, BIAS, RSB) do { const int ci_ = (IT) >> 2, h_ = (IT) & 3, base_ = ci_ * 128; const bool smp_ = ci_ >= 128; \
        if (tid < 128) { const f32x4 a_ = *(const f32x4*)(SSV + (size_t)(base_ + tid) * 8), b_ = *(const f32x4*)(SSV + (size_t)(base_ + tid) * 8 + 4); \
            (RSB)[tid] = rsqrtf(((a_[0] + a_[1]) + (a_[2] + a_[3]) + (b_[0] + b_[1]) + (b_[2] + b_[3])) * (1.f / 512.f) + EPS); } \
        const bf16_t* zr_ = Z + (size_t)(base_ + 2 * sp) * DIN + 1024 + h_ * 128 + d0; \
        q00 = *(const u32x4*)zr_; q01 = *(const u32x4*)(zr_ + 8); q10 = *(const u32x4*)(zr_ + DIN); q11 = *(const u32x4*)(zr_ + DIN + 8); \
        _Pragma("unroll") for (int n = 0; n < 8; ++n) (UU)[n] = *(const u32x2*)(Z + (size_t)(base_ + tl) * DIN + 512 + h_ * 128 + n * 16 + fq * 4); \
        (BIAS) = sgub[h_ * 128 + (smp_ ? (tl & 7) : tl)]; } while (0)
      if ((int)blockIdx.x < 136 * 4) SGU_LOAD((int)blockIdx.x, uu, bias, rs);
      for (int it = blockIdx.x; it < 136 * 4; it += gridDim.x, par ^= 1) {
        const int ci = it >> 2, h = it & 3, base = ci * 128; const bool smp = ci >= 128; const float* rsb = rs + par * 128;
        __syncthreads();
        { const size_t row = (size_t)(base + 2 * sp); const float r0 = rsb[2 * sp], r1 = rsb[2 * sp + 1];
#pragma unroll
          for (int hf = 0; hf < 2; ++hf) { const int dd = d0 + hf * 8; const f32x4 g0 = *(const f32x4*)(sng + h * 128 + dd), g1 = *(const f32x4*)(sng + h * 128 + dd + 4);
              f32x4 a0, a1, b0, b1; unpack8(hf ? q01 : q00, a0, a1); unpack8(hf ? q11 : q10, b0, b1);
              a0 = a0 * r0 * g0; a1 = a1 * r0 * g1; b0 = b0 * r1 * g0; b1 = b1 * r1 * g1;
#pragma unroll
              for (int j = 0; j < 4; ++j) { *(unsigned*)(Vt + (dd + j) * 136 + 2 * sp) = cvt_pk_bf16(a0[j], b0[j]); *(unsigned*)(Vt + (dd + 4 + j) * 136 + 2 * sp) = cvt_pk_bf16(a1[j], b1[j]); }
              if (smp) { float* o = out + O_NV + (row - MP) * 512 + h * 128 + dd; *(f32x4*)o = a0; *(f32x4*)(o + 4) = a1; *(f32x4*)(o + 512) = b0; *(f32x4*)(o + 516) = b1; } } }
        __syncthreads();
        const int itn = it + (int)gridDim.x;
        if (itn < 136 * 4) SGU_LOAD(itn, un, biasn, rs + (par ^ 1) * 128);
        { const bf16_t* Wm = (const bf16_t*)(ws + (smp ? OFF_WMS : OFF_WMP)) + h * 16384; const size_t erow = (size_t)(base + tl);
          f32x4 acc[8];
#pragma unroll
          for (int n = 0; n < 8; ++n) acc[n] = (f32x4){0.f, 0.f, 0.f, 0.f};
          const int nk = (16 * wave + 15) / 32 + 1;
          for (int kk = 0; kk < nk; ++kk) { const bf16x8 wf = *(const bf16x8*)(Wm + (16 * wave + fr) * 128 + kk * 32 + fq * 8);
#pragma unroll
              for (int n = 0; n < 8; ++n) { const bf16x8 vf = *(const bf16x8*)(Vt + (n * 16 + fr) * 136 + kk * 32 + fq * 8);
                  acc[n] = __builtin_amdgcn_mfma_f32_16x16x32_bf16(vf, wf, acc[n], 0, 0, 0); } }
#pragma unroll
          for (int n = 0; n < 8; ++n) { const int col = h * 128 + n * 16 + fq * 4;
              u32x2 w; w.x = cvt_pk_bf16(bf_lo(uu[n].x) * (acc[n][0] + bias), bf_hi(uu[n].x) * (acc[n][1] + bias)); w.y = cvt_pk_bf16(bf_lo(uu[n].y) * (acc[n][2] + bias), bf_hi(uu[n].y) * (acc[n][3] + bias));
              *(u32x2*)(Sd + erow * 512 + col) = w; } }
#pragma unroll
        for (int n = 0; n < 8; ++n) uu[n] = un[n];
        bias = biasn;
      }
#undef SGU_LOAD
    }
}

__device__ __forceinline__ void p6_conv(const Params& p) {
    unsigned char* ws = p.ws; const bf16_t* A2 = (const bf16_t*)(ws + OFF_A2); bf16_t* G2 = (bf16_t*)(ws + OFF_G2);
    const float* cw = p.in[I_CW]; const float* cb = p.in[I_CB]; const float* sc = p.in[I_SCONV]; float* out = p.out;
    const int total = (MT / 8) * 352;
    for (int it = blockIdx.x * 512 + threadIdx.x; it < total; it += gridDim.x * 512) {
        const int rg = it / 352, ch = (it - rg * 352) * 8, row0 = rg * 8;
        const f32x4 w0a = *(const f32x4*)(cw + ch), w0b = *(const f32x4*)(cw + ch + 4), w1a = *(const f32x4*)(cw + DFF + ch), w1b = *(const f32x4*)(cw + DFF + ch + 4);
        const f32x4 w2a = *(const f32x4*)(cw + 2 * DFF + ch), w2b = *(const f32x4*)(cw + 2 * DFF + ch + 4), ba = *(const f32x4*)(cb + ch), bb = *(const f32x4*)(cb + ch + 4);
        f32x4 p2a = (f32x4){0.f, 0.f, 0.f, 0.f}, p2b = p2a, p1a = p2a, p1b = p2a;
        const bool smp = row0 >= MP; const int db = (row0 - MP) >> 3;
        if (smp) { const float* s = sc + (size_t)db * 2 * DFF + ch; p2a = *(const f32x4*)s; p2b = *(const f32x4*)(s + 4); p1a = *(const f32x4*)(s + DFF); p1b = *(const f32x4*)(s + DFF + 4); }
        else if (row0 & 2047) { unpack8(*(const u32x4*)(A2 + (size_t)(row0 - 2) * DFF + ch), p2a, p2b); unpack8(*(const u32x4*)(A2 + (size_t)(row0 - 1) * DFF + ch), p1a, p1b); }
#pragma unroll
        for (int i = 0; i < 8; ++i) { const size_t o = (size_t)(row0 + i) * DFF + ch; f32x4 ca, cbv, ga, gb; unpack8(*(const u32x4*)(A2 + o), ca, cbv); unpack8(*(const u32x4*)(G2 + o), ga, gb);
            const f32x4 xa = w0a * p2a + w1a * p1a + w2a * ca + ba, xb = w0b * p2b + w1b * p1b + w2b * cbv + bb;
            u32x4 w; w.x = cvt_pk_bf16(gelu_tanh(xa[0]) * ga[0], gelu_tanh(xa[1]) * ga[1]); w.y = cvt_pk_bf16(gelu_tanh(xa[2]) * ga[2], gelu_tanh(xa[3]) * ga[3]);
            w.z = cvt_pk_bf16(gelu_tanh(xb[0]) * gb[0], gelu_tanh(xb[1]) * gb[1]); w.w = cvt_pk_bf16(gelu_tanh(xb[2]) * gb[2], gelu_tanh(xb[3]) * gb[3]);
            *(u32x4*)(G2 + o) = w;
            if (i >= 6) { if (smp) { float* q = out + O_NCS + ((size_t)db * 2 + (i - 6)) * DFF + ch; *(f32x4*)q = ca; *(f32x4*)(q + 4) = cbv; }
                          else if ((row0 & 2047) == 2040) { float* q = out + O_NCP + ((size_t)(row0 >> 11) * 2 + (i - 6)) * DFF + ch; *(f32x4*)q = ca; *(f32x4*)(q + 4) = cbv; } }
            p2a = p1a; p2b = p1b; p1a = ca; p1b = cbv; }
    }
}

__device__ __forceinline__ void p8_final(const Params& p, float* Yo, int rg0) {
    const int lane = threadIdx.x & 63, wave = threadIdx.x >> 6; const float* gf = p.in[I_FNG]; float* Y = p.out + O_Y;
    for (int rg = rg0 + blockIdx.x; rg < MT / 8; rg += gridDim.x) { const size_t row = (size_t)(rg * 8 + wave);
        f32x4 v[4]; float ss = 0.f;
#pragma unroll
        for (int i = 0; i < 4; ++i) { v[i] = *(const f32x4*)(Y + row * DM + i * 256 + lane * 4);
            if (row >= MP) { const float* pp = (const float*)(p.ws + OFF_A2) + (row - MP) * DM + i * 256 + lane * 4;
#pragma unroll
                for (int ks = 0; ks < 11; ++ks) v[i] += *(const f32x4*)(pp + (size_t)ks * ((size_t)(MT - MP) * DM)); }
            ss += v[i][0] * v[i][0] + v[i][1] * v[i][1] + v[i][2] * v[i][2] + v[i][3] * v[i][3]; }
        ss = wave_sum(ss); const float r = rsqrtf(ss * (1.f / 1024.f) + EPS);
#pragma unroll
        for (int i = 0; i < 4; ++i) { const f32x4 g = *(const f32x4*)(gf + i * 256 + lane * 4); *(f32x4*)(Yo + row * DM + i * 256 + lane * 4) = v[i] * r * g; } }
}

struct SampleOrder : pg8::StaticOrder {
    __device__ bool next(int i, Unit& u) const { if (c < 0) return false; if (!pg8::StaticOrder::next(i, u)) return false; u.pm += 64; return true; }
};
#define XB_TMO      128
#define XB_XCNT(j)  (256  + 64 * (j))
#define XB_XSUB(j)  (1280 + 64 * (j))
#define XB_XGEN(j)  (2304 + 64 * (j))
#define XB_TOP      3328
#define XB_TOPGEN   3392
#define XCD_BAR_WORDS 3456
#define XB_SPIN_CAP (1u << 18)
#define LAS __attribute__((address_space(3)))

__device__ __forceinline__ unsigned xb_ld(unsigned* p)              { return __hip_atomic_load(p, __ATOMIC_RELAXED, __HIP_MEMORY_SCOPE_AGENT); }
__device__ __forceinline__ unsigned xb_add(unsigned* p, unsigned v) { return __hip_atomic_fetch_add(p, v, __ATOMIC_RELAXED, __HIP_MEMORY_SCOPE_AGENT); }
__device__ __forceinline__ unsigned xb_xcc_id() { return (unsigned)__builtin_amdgcn_s_getreg((3 << 11) | 20) & 0xFu; }
#define XB_SPIN(cond, bar) do { unsigned _sp = 0; while (cond) { __builtin_amdgcn_s_sleep(1); \
    if ((++_sp & 255u) == 0u) { if (xb_ld(&(bar)[XB_TMO])) break; if (_sp > XB_SPIN_CAP) { atomicAdd(&(bar)[XB_TMO], 1u); break; } } } } while (0)

struct XcdBarrier {
    unsigned* bar; unsigned x;
    volatile LAS unsigned* st;
};

__device__ __forceinline__ XcdBarrier xcd_barrier_post(unsigned* bar, volatile LAS unsigned* st) {
    XcdBarrier b; b.bar = bar; b.x = xb_xcc_id(); b.st = st;
    if (threadIdx.x == 0) (void)xb_add(&bar[XB_XCNT(b.x)], 1u);
    return b;
}
__device__ __forceinline__ void xcd_barrier_complete(unsigned* bar, unsigned x, unsigned& nloc, unsigned& nx) {
    const unsigned G = gridDim.x * gridDim.y * gridDim.z;
    unsigned sum, cnt, mine, sp = 0u;
    for (;;) {
        sum = 0u; cnt = 0u; mine = 0u;
#pragma unroll
        for (unsigned j = 0; j < 16; ++j) { const unsigned c = xb_ld(&bar[XB_XCNT(j)]); sum += c; cnt += (c > 0u) ? 1u : 0u; mine = (j == x) ? c : mine; }
        if (sum == G) break;
        __builtin_amdgcn_s_sleep(1);
        if ((++sp & 255u) == 0u) { if (xb_ld(&bar[XB_TMO])) break; if (sp > XB_SPIN_CAP) { atomicAdd(&bar[XB_TMO], 1u); break; } }
    }
    nloc = mine > 0u ? mine : 1u; nx = cnt > 0u ? cnt : 1u;
}

__device__ __forceinline__ void xcd_barrier(const XcdBarrier& b) {
    asm volatile("s_waitcnt vmcnt(0)" ::: "memory");
    __syncthreads();
    if (threadIdx.x == 0) {
        unsigned* bar = b.bar;
        __builtin_amdgcn_s_waitcnt(0);
        unsigned nloc = b.st[0], nx = b.st[1];
        if (nloc == 0u) { xcd_barrier_complete(bar, b.x, nloc, nx); b.st[0] = nloc; b.st[1] = nx; }
        const unsigned old = xb_add(&bar[XB_XSUB(b.x)], 1u);
        const unsigned gen = old / nloc;
        if (old + 1u == (gen + 1u) * nloc) {
            __builtin_amdgcn_fence(__ATOMIC_RELEASE, "agent");
            asm volatile("s_waitcnt vmcnt(0)" ::: "memory");
            const unsigned og = xb_add(&bar[XB_TOP], 1u);
            const unsigned tg = og / nx;
            if (og + 1u == (tg + 1u) * nx) xb_add(&bar[XB_TOPGEN], 1u);
            else XB_SPIN(xb_ld(&bar[XB_TOPGEN]) == tg, bar);
            __builtin_amdgcn_fence(__ATOMIC_ACQUIRE, "agent");
            xb_add(&bar[XB_XGEN(b.x)], 1u);
            asm volatile("s_waitcnt vmcnt(0)" ::: "memory");
        } else {
            XB_SPIN(xb_ld(&bar[XB_XGEN(b.x)]) == gen, bar);
            __builtin_amdgcn_fence(__ATOMIC_ACQUIRE, "agent");
            asm volatile("s_waitcnt vmcnt(0)" ::: "memory");
        }
    }
    __syncthreads();
}


__global__ void __launch_bounds__(512, 2) fwd_mega(Params p) {
    extern __shared__ __attribute__((aligned(16))) unsigned char lds[];
    cg::grid_group grid = cg::this_grid();
    unsigned char* ws = p.ws; const int G = (int)gridDim.x, c = (int)blockIdx.x;
    PG8_LAS unsigned char* l3 = (PG8_LAS unsigned char*)lds;
    const int lo = p.ph_lo, hi = p.ph_hi;
#define IN(k) (lo <= (k) && (k) < hi)
    LAS unsigned* st = (LAS unsigned*)(l3 + ST_OFF);
    if (threadIdx.x == 0) { st[0] = 0u; st[1] = 0u; }
    __syncthreads();
    const XcdBarrier xbar = xcd_barrier_post((unsigned*)(ws + OFF_BAR), (volatile LAS unsigned*)st);
    if (hi > 1000) grid.sync();
#define SEAM(k) do { if (IN(k) && IN((k) + 1)) xcd_barrier(xbar); } while (0)
    if (IN(0)) { for (int rep = 0; rep < REP0; ++rep) { p0_prep(p, lds); __syncthreads(); } }
    SEAM(0);
    if (IN(1)) {
        { pg8::Gemm g{(const bf16_t*)(ws + OFF_WPO), (const bf16_t*)(ws + OFF_BPOOL), 1024, 512, 512, 512}; pg8::StaticOrder S; S.init(1024, 512, G, G - 1 - c);
          EpiPlain E{(bf16_t*)(ws + OFF_WEFF), 512}; pg8::gemm_phase<EpiPlain, pg8::StaticOrder, PG8_ALIGN, PG8_SP2>(l3, g, S, E); }
        { pg8::Gemm g{(const bf16_t*)(ws + OFF_R1), (const bf16_t*)(ws + OFF_WIN), MP, DIN, 1024, 1024}; EpiZ E{(bf16_t*)(ws + OFF_Z), (float*)(ws + OFF_SS)};
          { pg8::StaticOrder S; S.init(MP, DIN, G, c); pg8::gemm_phase<EpiZ, pg8::StaticOrder, PG8_ALIGN, PG8_SP2>(l3, g, S, E); }
          { SampleOrder S; S.init(MT - MP, DIN, G, G == 256 ? c - 128 : c); pg8::gemm_phase<EpiZ, SampleOrder, PG8_ALIGN, PG8_SP2>(l3, g, S, E); } }
    }
#if REP1 == 2
    if (IN(1)) {
        { pg8::Gemm g{(const bf16_t*)(ws + OFF_WPO), (const bf16_t*)(ws + OFF_BPOOL), 1024, 512, 512, 512}; pg8::StaticOrder S; S.init(1024, 512, G, G - 1 - c);
          EpiPlain E{(bf16_t*)(ws + OFF_WEFF), 512}; pg8::gemm_phase<EpiPlain, pg8::StaticOrder, PG8_ALIGN, PG8_SP2>(l3, g, S, E); }
        { pg8::Gemm g{(const bf16_t*)(ws + OFF_R1), (const bf16_t*)(ws + OFF_WIN), MT, DIN, 1024, 1024}; pg8::StaticOrder S; S.init(MT, DIN, G, c);
          EpiZ E{(bf16_t*)(ws + OFF_Z), (float*)(ws + OFF_SS)}; pg8::gemm_phase<EpiZ, pg8::StaticOrder, PG8_ALIGN, PG8_SP2>(l3, g, S, E); }
    }
#endif
    SEAM(1);
    if (IN(2)) { for (int rep = 0; rep < REP2; ++rep) { p2_mixer(p, lds); } }
    SEAM(2);
    if (IN(3)) {
        { pg8::Gemm g{(const bf16_t*)(ws + OFF_D), (const bf16_t*)(ws + OFF_WEFF), MP, 1024, 512, 512}; pg8::StaticOrder S; S.init(MP, 1024, G, c);
          EpiGate<0> E{(const bf16_t*)(ws + OFF_Z), (bf16_t*)(ws + OFF_MG), 1536}; pg8::gemm_phase<EpiGate<0>, pg8::StaticOrder, PG8_ALIGN, PG8_SP2>(l3, g, S, E); }
#ifndef DBG_SKIP_B
        { pg8::Gemm g{(const bf16_t*)(ws + OFF_S), (const bf16_t*)(ws + OFF_WSO), MP, 1024, 512, 512}; pg8::StaticOrder S; S.init(MP, 1024, G, c);
          EpiGate<1> E{(const bf16_t*)(ws + OFF_Z), (bf16_t*)(ws + OFF_MG), 2560}; pg8::gemm_phase<EpiGate<1>, pg8::StaticOrder, PG8_ALIGN, PG8_SP2>(l3, g, S, E); }
#endif
        small_ab(p);
    }
#if REP3 == 2
    if (IN(3)) {
        { pg8::Gemm g{(const bf16_t*)(ws + OFF_D), (const bf16_t*)(ws + OFF_WEFF), MP, 1024, 512, 512}; pg8::StaticOrder S; S.init(MP, 1024, G, c);
          EpiGate<0> E{(const bf16_t*)(ws + OFF_Z), (bf16_t*)(ws + OFF_MG), 1536}; pg8::gemm_phase<EpiGate<0>, pg8::StaticOrder, PG8_ALIGN, PG8_SP2>(l3, g, S, E); }
#ifndef DBG_SKIP_B
        { pg8::Gemm g{(const bf16_t*)(ws + OFF_S), (const bf16_t*)(ws + OFF_WSO), MP, 1024, 512, 512}; pg8::StaticOrder S; S.init(MP, 1024, G, c);
          EpiGate<1> E{(const bf16_t*)(ws + OFF_Z), (bf16_t*)(ws + OFF_MG), 2560}; pg8::gemm_phase<EpiGate<1>, pg8::StaticOrder, PG8_ALIGN, PG8_SP2>(l3, g, S, E); }
#endif
    }
#endif
    SEAM(3);
    if (IN(4)) {
        pg8::Gemm g{(const bf16_t*)(ws + OFF_MG), (const bf16_t*)(ws + OFF_WO), MP, 1024, 1024, 1024}; pg8::StaticOrder S; S.init(MP, 1024, G, c);
        if (G == 256) { EpiWoNorm E{p.in[I_XP], p.out + O_Y, (bf16_t*)(ws + OFF_R1), (float*)(ws + OFF_XS2), (unsigned*)(ws + OFF_CNT) + 64 * 64}; pg8::gemm_phase<EpiWoNorm, pg8::StaticOrder, false, PG8_SP2>(l3, g, S, E); }
        else { EpiRes<0> E{p.in[I_XP], p.in[I_XS], p.out + O_Y, (bf16_t*)(ws + OFF_R1), (float*)(ws + OFF_SS), p.out + O_Y}; pg8::gemm_phase<EpiRes<0>, pg8::StaticOrder, PG8_ALIGN, PG8_SP2>(l3, g, S, E); }
        small_o(p, lds);
    }
#if REP4 == 2
    if (IN(4)) {
        pg8::Gemm g{(const bf16_t*)(ws + OFF_MG), (const bf16_t*)(ws + OFF_WO), MP, 1024, 1024, 1024}; pg8::StaticOrder S; S.init(MP, 1024, G, c);
        EpiRes<0> E{p.in[I_XP], p.in[I_XS], p.out + O_Y, (bf16_t*)(ws + OFF_R1), (float*)(ws + OFF_SS), p.out + O_Y}; pg8::gemm_phase<EpiRes<0>, pg8::StaticOrder, PG8_ALIGN, PG8_SP2>(l3, g, S, E);
    }
#endif
    SEAM(4);
    if (IN(5)) {
        pg8::Gemm g{(const bf16_t*)(ws + OFF_R1), (const bf16_t*)(ws + OFF_WUG), MP, 2 * DFF, 1024, 1024};
        EpiUGConv E{(const float*)(ws + OFF_SS), (bf16_t*)(ws + OFF_G2), (float*)(ws + OFF_EA), (float*)(ws + OFF_EG), p.in[I_CW], p.in[I_CB], p.in[I_SCONV], p.out, (PG8_LAS float*)(l3 + HALO_OFF), G == 256 ? 1 : 0};
        { pg8::StaticOrder S; S.init(MP, 2 * DFF, G, c); pg8::gemm_phase<EpiUGConv, pg8::StaticOrder, PG8_ALIGN, PG8_SP2>(l3, g, S, E); }
        { SampleOrder S; S.init(MT - MP, 2 * DFF, G, G == 256 ? c - 128 : c); pg8::gemm_phase<EpiUGConv, SampleOrder, PG8_ALIGN, PG8_SP2>(l3, g, S, E); }
    }
    SEAM(5);
#if REP5 == 2
    grid.sync();
    if (IN(5)) {
        pg8::Gemm g{(const bf16_t*)(ws + OFF_R1), (const bf16_t*)(ws + OFF_WUG), MT, 2 * DFF, 1024, 1024}; pg8::StaticOrder S; S.init(MT, 2 * DFF, G, c);
        EpiUG E{(const float*)(ws + OFF_SS), (bf16_t*)(ws + OFF_A2), (bf16_t*)(ws + OFF_G2)}; pg8::gemm_phase<EpiUG, pg8::StaticOrder, PG8_ALIGN, PG8_SP2>(l3, g, S, E);
    }
    SEAM(5);
    if (IN(6)) p6_conv(p);
#endif
    if (IN(7)) {
#if REP7 == 2
        { pg8::Gemm g{(const bf16_t*)(ws + OFF_G2), (const bf16_t*)(ws + OFF_WD), MP, 1024, DFF, DFF}; pg8::StaticOrder S; S.init(MP, 1024, G, c);
          EpiRes<1> E{nullptr, nullptr, p.out + O_Y, nullptr, nullptr, (float*)(ws + OFF_A2)}; pg8::gemm_phase<EpiRes<1>, pg8::StaticOrder, PG8_ALIGN, PG8_SP2>(l3, g, S, E); xcd_barrier(xbar); }
#endif
        { pg8::Gemm g{(const bf16_t*)(ws + OFF_G2), (const bf16_t*)(ws + OFF_WD), MP, 1024, DFF, DFF}; pg8::StaticOrder S; S.init(MP, 1024, G, c);
          { Unit uu; for (int i = 0; S.next(i, uu); ++i) if ((uu.pm & 7) != 0) p6_fix(p, uu.pm); }
          if (G == 256) { EpiDownNorm E{p.out + O_Y, p.in[I_FNG], (float*)(ws + OFF_XS), (unsigned*)(ws + OFF_CNT)}; pg8::gemm_phase<EpiDownNorm, pg8::StaticOrder, false, PG8_SP2>(l3, g, S, E); }
          else { EpiRes<1> E{nullptr, nullptr, p.out + O_Y, nullptr, nullptr, p.out + O_Y}; pg8::gemm_phase<EpiRes<1>, pg8::StaticOrder, PG8_ALIGN, PG8_SP2>(l3, g, S, E); } }
        { pg8::Gemm g{(const bf16_t*)(ws + OFF_G2) + (size_t)MP * DFF, (const bf16_t*)(ws + OFF_WD), MT - MP, 1024, 256, DFF}; pg8::SplitKOrder S; S.init(MT - MP, 1024, 11, 256, G, c);
          EpiPartial E{(float*)(ws + OFF_A2), 256}; pg8::gemm_phase<EpiPartial, pg8::SplitKOrder, PG8_ALIGN, PG8_SP2>(l3, g, S, E); }
    }
    SEAM(7);
#if REP8 == 2
    if (IN(8)) { p8_final(p, (float*)(p.ws + OFF_G2), 0); xcd_barrier(xbar); }
#endif
    if (IN(8)) p8_final(p, p.out + O_Y, G == 256 ? MP / 8 : 0);
#if REPSYNC > 0
    grid.sync(); grid.sync(); grid.sync(); grid.sync(); grid.sync(); grid.sync(); grid.sync(); grid.sync();
#endif
#ifdef DBG_DUMP
    if (IN(9)) dbg_dump(p);
#endif
}

extern "C" void kernel_launch(void* const* d_in, const int* in_sizes, int n_in, void* d_out, int out_size, void* d_ws, size_t ws_size, hipStream_t stream) {
    static int grid_blocks = 0;
    if (!grid_blocks) {
        int dev = 0, cus = 0, per_cu = 0;
        (void)hipGetDevice(&dev);
        (void)hipDeviceGetAttribute(&cus, hipDeviceAttributeMultiprocessorCount, dev);
        (void)hipFuncSetAttribute((const void*)fwd_mega, hipFuncAttributeMaxDynamicSharedMemorySize, LDS_BYTES);
        (void)hipOccupancyMaxActiveBlocksPerMultiprocessor(&per_cu, (const void*)fwd_mega, 512, LDS_BYTES);
        if (per_cu < 1) per_cu = 1;
        grid_blocks = cus * per_cu;
        if (ws_size < WS_END + BAR_BYTES + CNT_BYTES) fprintf(stderr, "kernel_launch: workspace too small: %zu < %zu\n", ws_size, (size_t)WS_END);
    }
#ifdef DBG_MEMSET
    (void)hipMemsetAsync(d_ws, 0, WS_END, stream);
#endif
    (void)hipMemsetAsync((unsigned char*)d_ws + OFF_BAR, 0, BAR_BYTES + CNT_BYTES, stream);
    Params p{};
    for (int i = 0; i < 21; ++i) p.in[i] = (const float*)d_in[i];
    p.out = (float*)d_out; p.ws = (unsigned char*)d_ws;
#if N_LAUNCHES == 1
    p.ph_lo = 0; p.ph_hi = NPHASE;
    void* args[] = {&p};
    hipError_t e = hipLaunchCooperativeKernel((const void*)fwd_mega, dim3(grid_blocks), dim3(512), args, LDS_BYTES, stream);
    if (e != hipSuccess) fprintf(stderr, "cooperative launch failed: %s (grid %d)\n", hipGetErrorString(e), grid_blocks);
#else
    for (int k = 0; k < DBG_HI; ++k) { p.ph_lo = k; p.ph_hi = k + 1; hipLaunchKernelGGL(fwd_mega, dim3(grid_blocks), dim3(512), LDS_BYTES, stream, p); }
#ifdef DBG_DUMP
    p.ph_lo = 9; p.ph_hi = 10; hipLaunchKernelGGL(fwd_mega, dim3(grid_blocks), dim3(512), LDS_BYTES, stream, p);
#endif
#endif
}
```

```cpp
#include <hip/hip_runtime.h>
#include <hip/hip_cooperative_groups.h>
#include <cstdio>
namespace cg = cooperative_groups;
namespace pg8 {
#define PG8_LAS __attribute__((address_space(3)))
typedef unsigned short bf16_t;
typedef short bf16x8 __attribute__((ext_vector_type(8)));
typedef float f32x4 __attribute__((ext_vector_type(4)));
typedef unsigned u32x4 __attribute__((ext_vector_type(4)));
constexpr int BM = 256, BK = 64, HALF = 128, HTB = HALF * BK * 2  , STAGE_BYTES = 8 * HTB, NXCD = 8, WGM = 8;

__host__ __device__ __forceinline__ int lds_byte(int r, int c) { const int st = (r >> 4) * 2 + (c >> 5), rr = r & 15, cc = c & 31, ob = rr * 64 + cc * 2; return st * 1024 + (ob ^ (((ob >> 9) & 1) << 5)); }
__host__ __device__ __forceinline__ void stage_rc(int b, int& R, int& C) { const int st = b / 1024, sb = b % 1024, swz = sb ^ (((sb >> 9) & 1) << 5); R = (st >> 1) * 16 + swz / 64; C = (st & 1) * 32 + (swz % 64) / 2; }
__host__ __device__ __forceinline__ int perm32(int rho) { const int n = rho >> 4, i = rho & 15; return 8 * (i >> 2) + 4 * n + (i & 3); }

struct Unit { int pm, pn, ko; };
struct Gemm { const bf16_t* A; const bf16_t* Bt; int M, N, K, ld; };

struct StaticOrder {
    int nM, nN, nwg, G, c;
    __host__ __device__ void init(int M, int N, int G_, int c_) { nM = M / BM; nN = N / BM; nwg = nM * nN; G = G_; c = c_; }
    __host__ __device__ bool next(int i, Unit& u) const {
        const long L = (long)i * G + c; if (L >= nwg) return false;
        int wgid = (int)L; { const int q = nwg / NXCD, r = nwg % NXCD, xcd = wgid % NXCD, off = wgid / NXCD; wgid = (xcd < r ? xcd * (q + 1) : r * (q + 1) + (xcd - r) * q) + off; }
        const int nig = WGM * nN, gid = wgid / nig, fm = gid * WGM, gsz = (nM - fm) < WGM ? (nM - fm) : WGM;
        u.pm = fm + ((wgid % nig) % gsz); u.pn = (wgid % nig) / gsz; u.ko = 0; return true;
    }
    __device__ __forceinline__ void a_ready(const Unit&) const {}
    __device__ __forceinline__ void done(const Unit&) const {}
};
struct SplitKOrder {
    int nM, nN, nS, kext, G, c;
    __host__ __device__ void init(int M, int N, int nS_, int kext_, int G_, int c_) { nM = M / BM; nN = N / BM; nS = nS_; kext = kext_; G = G_; c = c_; }
    __host__ __device__ bool next(int i, Unit& u) const { const int L = i * G + c; if (L >= nM * nN * nS) return false; const int ks = L / (nM * nN), rem = L - ks * (nM * nN); u.pm = rem % nM; u.pn = rem / nM; u.ko = ks * kext; return true; }
    __device__ __forceinline__ void a_ready(const Unit&) const {}
    __device__ __forceinline__ void done(const Unit&) const {}
};
typedef __bf16 bf16x2_t __attribute__((ext_vector_type(2)));
typedef float f32x2_t __attribute__((ext_vector_type(2)));
__device__ __forceinline__ unsigned cvt_pk_bf16(float lo, float hi) { f32x2_t v = {lo, hi}; bf16x2_t b = __builtin_convertvector(v, bf16x2_t); return __builtin_bit_cast(unsigned, b); }
typedef float f32x2 __attribute__((ext_vector_type(2)));
template <class Epi, class Sched, bool ALIGN_EPI = false, bool SP2 = false>
__device__ __forceinline__ void gemm_phase(PG8_LAS unsigned char* lds, const Gemm g, const Sched& S, const Epi& E) {
    const int tid = threadIdx.x, wid = __builtin_amdgcn_readfirstlane(tid >> 6), lane = tid & 63, wr = wid >> 2, wc = wid & 3, fr = lane & 15, fq = lane >> 4;
    const int K = g.ld, nt = g.K / BK;
    unsigned voffA[2], voffB[2];
#pragma unroll
    for (int i = 0; i < 2; ++i) { int R, C; stage_rc(tid * 16 + i * 8192, R, C); const int Rb = Epi::PERM ? ((R & ~31) + perm32(R & 31)) : R;
        voffA[i] = (unsigned)(R * K + C) * 2u; voffB[i] = (unsigned)(Rb * K + C) * 2u; }
    const size_t kstep = (size_t)(BK * 2);
    const size_t hstep = (size_t)HALF * K * 2;
    const size_t tstep = 2 * hstep;
    const unsigned ldsw = (unsigned)wid * 1024u;
    const int aoff = lds_byte(wr * 64 + fr, fq * 8), boff = lds_byte(wc * 32 + fr, fq * 8);
#define PG8_SA(b, h) (((b) * 2 + (h)) * HTB)
#define PG8_SB(b, h) ((4 + (b) * 2 + (h)) * HTB)
#define PG8_STAGE(bufoff, gbase, voff) do { _Pragma("unroll") for (int _i = 0; _i < 2; ++_i) \
        __builtin_amdgcn_global_load_lds((const unsigned*)((const char*)(gbase) + (voff)[_i]), (PG8_LAS unsigned*)(lds + (bufoff) + ldsw + _i * 8192), 16, 0, 0); } while (0)
#define PG8_LDA(dst, b, h) do { _Pragma("unroll") for (int m = 0; m < 4; ++m) _Pragma("unroll") for (int k = 0; k < 2; ++k) dst[m][k] = *(const PG8_LAS bf16x8*)(lds + PG8_SA(b, h) + aoff + m * 2048 + k * 1024); } while (0)
#define PG8_LDB(dst, b, h) do { _Pragma("unroll") for (int n = 0; n < 2; ++n) _Pragma("unroll") for (int k = 0; k < 2; ++k) dst[n][k] = *(const PG8_LAS bf16x8*)(lds + PG8_SB(b, h) + boff + n * 2048 + k * 1024); } while (0)
#define PG8_MMA(ai, bj, At, Bt) do { __builtin_amdgcn_s_setprio(1); _Pragma("unroll") for (int m = 0; m < 4; ++m) _Pragma("unroll") for (int n = 0; n < 2; ++n) _Pragma("unroll") for (int k = 0; k < 2; ++k) \
        acc[ai][bj][m][n] = __builtin_amdgcn_mfma_f32_16x16x32_bf16(Bt[n][k], At[m][k], acc[ai][bj][m][n], 0, 0, 0); __builtin_amdgcn_s_setprio(0); } while (0)
#define PG8_WAIT_V(n) asm volatile("s_waitcnt vmcnt(" #n ")" ::: "memory")
#define PG8_WAIT_L(n) asm volatile("s_waitcnt lgkmcnt(" #n ")" ::: "memory")
#define PG8_BAR __builtin_amdgcn_s_barrier()
#define PG8_SCHED __builtin_amdgcn_sched_barrier(0)
    Unit cur, nxt; int ui = 0;
    if (!S.next(0, cur)) return;
    f32x4 acc[2][2][4][2];
#pragma unroll
    for (int a = 0; a < 2; ++a)
#pragma unroll
        for (int b = 0; b < 2; ++b)
#pragma unroll
            for (int m = 0; m < 4; ++m)
#pragma unroll
                for (int n = 0; n < 2; ++n) acc[a][b][m][n] = (f32x4){0.f, 0.f, 0.f, 0.f};
    bf16x8 At[4][2], B0[2][2], B1[2][2];
    const char* cA = (const char*)g.A + (size_t)cur.pm * tstep + (size_t)cur.ko * 2; const char* cB = (const char*)g.Bt + (size_t)cur.pn * tstep + (size_t)cur.ko * 2;
    S.a_ready(cur);
    if constexpr (SP2) {
        PG8_STAGE(PG8_SB(0, 0), cB, voffB); PG8_STAGE(PG8_SB(0, 1), cB + hstep, voffB); PG8_STAGE(PG8_SA(0, 0), cA, voffA); PG8_STAGE(PG8_SA(0, 1), cA + hstep, voffA);
        if (wr == 1) PG8_BAR;
        PG8_WAIT_V(2); PG8_BAR;
        PG8_STAGE(PG8_SB(1, 0), cB + kstep, voffB); PG8_STAGE(PG8_SA(1, 0), cA + kstep, voffA); PG8_STAGE(PG8_SB(1, 1), cB + hstep + kstep, voffB);
        PG8_WAIT_V(6); PG8_BAR;
    } else {
        PG8_STAGE(PG8_SB(0, 0), cB, voffB); PG8_STAGE(PG8_SA(0, 0), cA, voffA); PG8_STAGE(PG8_SB(0, 1), cB + hstep, voffB); PG8_STAGE(PG8_SA(0, 1), cA + hstep, voffA);
        if (wr == 1) PG8_BAR;
        PG8_WAIT_V(4); PG8_BAR;
        PG8_STAGE(PG8_SB(1, 0), cB + kstep, voffB); PG8_STAGE(PG8_SA(1, 0), cA + kstep, voffA); PG8_STAGE(PG8_SB(1, 1), cB + hstep + kstep, voffB);
        PG8_WAIT_V(6); PG8_BAR;
    }
    for (;;) {
        const bool has_next = S.next(ui + 1, nxt);
        const char* nA = has_next ? (const char*)g.A + (size_t)nxt.pm * tstep + (size_t)nxt.ko * 2 : cA; const char* nB = has_next ? (const char*)g.Bt + (size_t)nxt.pn * tstep + (size_t)nxt.ko * 2 : cB;
        for (int t = 0; t < nt; t += 2) {
            const bool last = (t == nt - 2);
            const char* a1 = cA + (size_t)(t + 1) * kstep;
            const char* a2 = last ? nA : cA + (size_t)(t + 2) * kstep; const char* b2 = last ? nB : cB + (size_t)(t + 2) * kstep;
            const char* a3 = a2 + kstep; const char* b3 = b2 + kstep;
            if (last && has_next) S.a_ready(nxt);
            if constexpr (SP2) {
            PG8_LDB(B0, 0, 0); PG8_LDB(B1, 0, 1); PG8_SCHED; PG8_LDA(At, 0, 0); PG8_STAGE(PG8_SA(1, 1), a1 + hstep, voffA);
            PG8_WAIT_V(8); PG8_WAIT_L(0); PG8_BAR; PG8_MMA(0, 0, At, B0); PG8_MMA(0, 1, At, B1); PG8_BAR; PG8_SCHED;
            PG8_LDA(At, 0, 1); PG8_STAGE(PG8_SB(0, 0), b2, voffB); PG8_STAGE(PG8_SB(0, 1), b2 + hstep, voffB); PG8_STAGE(PG8_SA(0, 0), a2, voffA);
            PG8_WAIT_V(8); PG8_WAIT_L(0); PG8_BAR; PG8_MMA(1, 0, At, B0); PG8_MMA(1, 1, At, B1); PG8_BAR; PG8_SCHED;
            PG8_LDB(B0, 1, 0); PG8_LDB(B1, 1, 1); PG8_SCHED; PG8_LDA(At, 1, 0); PG8_STAGE(PG8_SA(0, 1), a2 + hstep, voffA);
            PG8_WAIT_V(8); PG8_WAIT_L(0); PG8_BAR; PG8_MMA(0, 0, At, B0); PG8_MMA(0, 1, At, B1); PG8_BAR; PG8_SCHED;
            PG8_LDA(At, 1, 1); PG8_STAGE(PG8_SB(1, 0), b3, voffB); PG8_STAGE(PG8_SB(1, 1), b3 + hstep, voffB); PG8_STAGE(PG8_SA(1, 0), a3, voffA);
            PG8_WAIT_V(8); PG8_WAIT_L(0); PG8_BAR; PG8_MMA(1, 0, At, B0); PG8_MMA(1, 1, At, B1); PG8_BAR; PG8_SCHED;
            } else {
            PG8_LDB(B0, 0, 0); PG8_SCHED; PG8_LDA(At, 0, 0); PG8_STAGE(PG8_SA(1, 1), a1 + hstep, voffA);
            PG8_WAIT_L(8); PG8_BAR; PG8_WAIT_L(0); PG8_MMA(0, 0, At, B0); PG8_BAR; PG8_SCHED;
            PG8_LDB(B1, 0, 1); PG8_STAGE(PG8_SB(0, 0), b2, voffB);
            PG8_BAR; PG8_WAIT_L(0); PG8_MMA(0, 1, At, B1); PG8_BAR;
            PG8_LDA(At, 0, 1); PG8_STAGE(PG8_SA(0, 0), a2, voffA);
            PG8_BAR; PG8_WAIT_L(0); PG8_MMA(1, 0, At, B0); PG8_BAR; PG8_SCHED;
            PG8_STAGE(PG8_SB(0, 1), b2 + hstep, voffB);
            PG8_WAIT_V(6); PG8_BAR; PG8_MMA(1, 1, At, B1); PG8_BAR;
            PG8_LDB(B0, 1, 0); PG8_SCHED; PG8_LDA(At, 1, 0); PG8_STAGE(PG8_SA(0, 1), a2 + hstep, voffA);
            PG8_WAIT_L(8); PG8_BAR; PG8_WAIT_L(0); PG8_MMA(0, 0, At, B0); PG8_BAR; PG8_SCHED;
            PG8_LDB(B1, 1, 1); PG8_STAGE(PG8_SB(1, 0), b3, voffB);
            PG8_BAR; PG8_WAIT_L(0); PG8_MMA(0, 1, At, B1); PG8_BAR;
            PG8_LDA(At, 1, 1); PG8_STAGE(PG8_SA(1, 0), a3, voffA);
            PG8_BAR; PG8_WAIT_L(0); PG8_MMA(1, 0, At, B0); PG8_BAR; PG8_SCHED;
            PG8_STAGE(PG8_SB(1, 1), b3 + hstep, voffB);
            PG8_WAIT_V(6); PG8_BAR; PG8_MMA(1, 1, At, B1); PG8_BAR;
            }
        }
        if constexpr (ALIGN_EPI) { if (wr == 0) PG8_BAR; }
        if constexpr (!Epi::AFTER_DRAIN) { E(acc, cur, wr, wc, fr, fq); S.done(cur); }
        if (!has_next) break;
#pragma unroll
        for (int a = 0; a < 2; ++a)
#pragma unroll
            for (int b = 0; b < 2; ++b)
#pragma unroll
                for (int m = 0; m < 4; ++m)
#pragma unroll
                    for (int n = 0; n < 2; ++n) acc[a][b][m][n] = (f32x4){0.f, 0.f, 0.f, 0.f};
        cur = nxt; cA = nA; cB = nB; ++ui;
        if constexpr (ALIGN_EPI) { if (wr == 1) PG8_BAR; }
    }
    PG8_WAIT_V(0);
    if constexpr (!ALIGN_EPI) { if (wr == 0) PG8_BAR; }
    PG8_BAR;
    if constexpr (Epi::AFTER_DRAIN) { E.fused(acc, cur, wr, wc, fr, fq, lds, wid, lane); S.done(cur); }
#undef PG8_SA
#undef PG8_SB
#undef PG8_STAGE
#undef PG8_LDA
#undef PG8_LDB
#undef PG8_MMA
#undef PG8_WAIT_V
#undef PG8_WAIT_L
#undef PG8_BAR
#undef PG8_SCHED
}
}

using pg8::bf16_t; using pg8::f32x4; using pg8::u32x4; using pg8::bf16x8; using pg8::Unit; using pg8::cvt_pk_bf16;
typedef unsigned u32x2 __attribute__((ext_vector_type(2)));
#define REP0 1
#define REP1 1
#define REP2 1
#define REP3 1
#define REP4 1
#define REP5 1
#define REP7 1
#define REP8 1
#define REPSYNC 0
#ifndef DBG_HI
#define DBG_HI NPHASE
#endif
#ifndef N_LAUNCHES
#define N_LAUNCHES 1
#endif
#ifndef PG8_SP2
#define PG8_SP2 true
#endif
#ifndef PG8_ALIGN
#define PG8_ALIGN true
#endif
constexpr int NPHASE = 9;
constexpr int DM = 1024, MP = 16384, MT = 17408, DIN = 3584, DFF = 2816;
constexpr float EPS = 1e-6f;
constexpr size_t OFF_WIN = 0;
constexpr size_t OFF_WPO = OFF_WIN + 7340032;
constexpr size_t OFF_BPOOL = OFF_WPO + 1048576;
constexpr size_t OFF_WEFF = OFF_BPOOL + 524288;
constexpr size_t OFF_WSO = OFF_WEFF + 1048576;
constexpr size_t OFF_WO = OFF_WSO + 1048576;
constexpr size_t OFF_WUG = OFF_WO + 2097152;
constexpr size_t OFF_WD = OFF_WUG + 11534336;
constexpr size_t OFF_WMP = OFF_WD + 5767168;
constexpr size_t OFF_WMS = OFF_WMP + 131072;
constexpr size_t OFF_SS = OFF_WMS + 131072;
constexpr size_t OFF_R1 = OFF_SS + 1114112;
constexpr size_t OFF_R2 = OFF_R1 + 35651584;
constexpr size_t OFF_Z = OFF_R2, OFF_D = OFF_Z + 124780544, OFF_S = OFF_D + 17825792, OFF_MG = OFF_S + 17825792;
constexpr size_t OFF_A2 = OFF_R2, OFF_G2 = OFF_A2 + 98041856;
constexpr size_t WS_END = OFF_G2 + 98041856;
constexpr size_t OFF_BAR = WS_END;
constexpr size_t BAR_BYTES = 3456 * 4;
constexpr size_t OFF_CNT = OFF_BAR + BAR_BYTES;
constexpr size_t CNT_BYTES = 128 * 256;
constexpr size_t OFF_XS2 = OFF_A2 + 58720256 + 262144;
constexpr size_t OFF_XS = OFF_A2 + 58720256;
constexpr int HALO_OFF = 131072, HALO_BYTES = 4096, ST_OFF = HALO_OFF + HALO_BYTES;
constexpr int LDS_BYTES = ST_OFF + 64;
constexpr size_t OFF_EA = OFF_A2 + 50331648;
constexpr size_t OFF_EG = OFF_EA + 3063808;
static_assert(OFF_MG + 35651584 == WS_END, "region R2 overlay");
constexpr size_t O_Y = 0, O_NPP = 17825792, O_NPS = O_NPP + 61440, O_NCP = O_NPS + 983040, O_NCS = O_NCP + 45056, O_NV = O_NCS + 720896;

struct Params { const float* in[21]; float* out; unsigned char* ws; int ph_lo, ph_hi; };
enum { I_XP = 0, I_XS, I_SPOOL, I_SCONV, I_N1G, I_WIN, I_POOLW, I_PSCALE, I_WPO, I_SNG, I_SGUW, I_SGUB, I_WSO, I_WO, I_N2G, I_WUP, I_WGATE, I_CW, I_CB, I_WDOWN, I_FNG };

__device__ __forceinline__ float bf_lo(unsigned w) { return __uint_as_float(w << 16); }
__device__ __forceinline__ float bf_hi(unsigned w) { return __uint_as_float(w & 0xffff0000u); }
__device__ __forceinline__ unsigned short f2bf(float f) { return (unsigned short)(cvt_pk_bf16(f, 0.f) & 0xffffu); }
__device__ __forceinline__ float gelu_tanh(float x) { const float t = x * (1.f + 0.044715f * x * x); const float e = __builtin_amdgcn_exp2f(-2.3022082f * t); return x * __builtin_amdgcn_rcpf(1.f + e); }
__device__ __forceinline__ float sigm(float x) { return __builtin_amdgcn_rcpf(1.f + __builtin_amdgcn_exp2f(-1.44269504f * x)); }
__device__ __forceinline__ float wave_sum(float v) { v += __shfl_xor(v, 1); v += __shfl_xor(v, 2); v += __shfl_xor(v, 4); v += __shfl_xor(v, 8); v += __shfl_xor(v, 16); v += __shfl_xor(v, 32); return v; }

__device__ __forceinline__ void unpack8(const u32x4 q, f32x4& a, f32x4& b) { a[0] = bf_lo(q.x); a[1] = bf_hi(q.x); a[2] = bf_lo(q.y); a[3] = bf_hi(q.y); b[0] = bf_lo(q.z); b[1] = bf_hi(q.z); b[2] = bf_lo(q.w); b[3] = bf_hi(q.w); }
__device__ __forceinline__ u32x4 pack8(const f32x4 a, const f32x4 b) { u32x4 w; w.x = cvt_pk_bf16(a[0], a[1]); w.y = cvt_pk_bf16(a[2], a[3]); w.z = cvt_pk_bf16(b[0], b[1]); w.w = cvt_pk_bf16(b[2], b[3]); return w; }

struct TJob { const float* src; bf16_t* dst; const float* kscale; int K, N, grp, gstride, off; };
__device__ __forceinline__ void transpose_tile(const TJob& j, int tk, int tn, float* tile) {
    const int tid = threadIdx.x;
#pragma unroll
    for (int p = 0; p < 2; ++p) {
        const int r = (tid >> 4) + p * 32, c4 = (tid & 15) * 4, k = tk * 64 + r;
        const float4 v = *(const float4*)(j.src + (size_t)k * j.N + tn * 64 + c4);
        const float s = j.kscale ? j.kscale[k] : 1.f;
        tile[r * 65 + c4 + 0] = v.x * s; tile[r * 65 + c4 + 1] = v.y * s; tile[r * 65 + c4 + 2] = v.z * s; tile[r * 65 + c4 + 3] = v.w * s;
    }
    __syncthreads();
    const int n = tid >> 3, k8 = (tid & 7) * 8;
    u32x4 w;
    w.x = cvt_pk_bf16(tile[(k8 + 0) * 65 + n], tile[(k8 + 1) * 65 + n]); w.y = cvt_pk_bf16(tile[(k8 + 2) * 65 + n], tile[(k8 + 3) * 65 + n]);
    w.z = cvt_pk_bf16(tile[(k8 + 4) * 65 + n], tile[(k8 + 5) * 65 + n]); w.w = cvt_pk_bf16(tile[(k8 + 6) * 65 + n], tile[(k8 + 7) * 65 + n]);
    const int ng = tn * 64 + n, drow = (ng / j.grp) * j.gstride + (ng % j.grp) + j.off;
    *(u32x4*)(j.dst + (size_t)drow * j.K + tk * 64 + k8) = w;
    __syncthreads();
}
__device__ __forceinline__ void p0_prep(const Params& p, unsigned char* lds) {
    unsigned char* ws = p.ws; const int tid = threadIdx.x, lane = tid & 63, wave = tid >> 6;
    for (int t = blockIdx.x; t < 3520; t += gridDim.x) {
        TJob j; int lt = t;
        if (lt < 896) { j = TJob{p.in[I_WIN], (bf16_t*)(ws + OFF_WIN), nullptr, 1024, 3584, 3584, 0, 0}; }
        else if ((lt -= 896) < 128) { j = TJob{p.in[I_WPO], (bf16_t*)(ws + OFF_WPO), nullptr, 512, 1024, 1024, 0, 0}; }
        else if ((lt -= 128) < 128) { j = TJob{p.in[I_WSO], (bf16_t*)(ws + OFF_WSO), nullptr, 512, 1024, 1024, 0, 0}; }
        else if ((lt -= 128) < 256) { j = TJob{p.in[I_WO], (bf16_t*)(ws + OFF_WO), nullptr, 1024, 1024, 1024, 0, 0}; }
        else if ((lt -= 256) < 704) { j = TJob{p.in[I_WUP], (bf16_t*)(ws + OFF_WUG), p.in[I_N2G], 1024, 2816, 128, 256, 0}; }
        else if ((lt -= 704) < 704) { j = TJob{p.in[I_WGATE], (bf16_t*)(ws + OFF_WUG), p.in[I_N2G], 1024, 2816, 128, 256, 128}; }
        else { lt -= 704; j = TJob{p.in[I_WDOWN], (bf16_t*)(ws + OFF_WD), nullptr, 2816, 1024, 1024, 0, 0}; }
        const int ntn = j.N / 64;
        transpose_tile(j, lt / ntn, lt % ntn, (float*)lds);
    }
    const int gt = blockIdx.x * 512 + tid, gs = gridDim.x * 512;
    { bf16_t* bp = (bf16_t*)(ws + OFF_BPOOL); const float* pw = p.in[I_POOLW]; const float* ps = p.in[I_PSCALE];
      for (int i = gt; i < 512 * 512; i += gs) { const int k = i >> 9, jn = i & 511; float v = 0.f; if ((k >> 7) == (jn >> 7)) v = pw[(k >> 7) * 16384 + (k & 127) * 128 + (jn & 127)] * ps[jn]; bp[i] = f2bf(v); } }
    { bf16_t* wp = (bf16_t*)(ws + OFF_WMP); bf16_t* wsm = (bf16_t*)(ws + OFF_WMS); const float* sw = p.in[I_SGUW];
      for (int i = gt; i < 4 * 128 * 128; i += gs) { const int h = i >> 14, t = (i >> 7) & 127, s = i & 127;
          wp[i] = f2bf(s <= t ? sw[i] : 0.f);
          wsm[i] = f2bf(((t >> 3) == (s >> 3) && (s & 7) <= (t & 7)) ? sw[h * 16384 + (t & 7) * 128 + (s & 7)] : 0.f); } }
    { bf16_t* H = (bf16_t*)(ws + OFF_R1); const float* g1 = p.in[I_N1G];
      for (int rg = blockIdx.x; rg < MT / 8; rg += gridDim.x) {
          const int row = rg * 8 + wave; const float* xr = row < MP ? p.in[I_XP] + (size_t)row * DM : p.in[I_XS] + (size_t)(row - MP) * DM;
          f32x4 v[4]; float ss = 0.f;
#pragma unroll
          for (int i = 0; i < 4; ++i) { v[i] = *(const f32x4*)(xr + i * 256 + lane * 4); ss += v[i][0] * v[i][0] + v[i][1] * v[i][1] + v[i][2] * v[i][2] + v[i][3] * v[i][3]; }
          ss = wave_sum(ss); const float r = rsqrtf(ss * (1.f / 1024.f) + EPS);
#pragma unroll
          for (int i = 0; i < 4; ++i) { const f32x4 g = *(const f32x4*)(g1 + i * 256 + lane * 4); u32x2 w; w.x = cvt_pk_bf16(v[i][0] * r * g[0], v[i][1] * r * g[1]); w.y = cvt_pk_bf16(v[i][2] * r * g[2], v[i][3] * r * g[3]);
              *(u32x2*)(H + (size_t)row * DM + i * 256 + lane * 4) = w; }
      } }
}

template <int ACT> __device__ __forceinline__ void store_bf16_tile(const f32x4 (&acc)[2][2][4][2], bf16_t* O, int ld, int row0, int col0) {
#pragma unroll
    for (int ai = 0; ai < 2; ++ai)
#pragma unroll
        for (int m = 0; m < 4; ++m) { bf16_t* rowp = O + (size_t)(row0 + ai * 128 + m * 16) * ld + col0;
#pragma unroll
            for (int bj = 0; bj < 2; ++bj) { f32x4 v0 = acc[ai][bj][m][0], v1 = acc[ai][bj][m][1];
                if (ACT == 1) {
#pragma unroll
                    for (int j = 0; j < 4; ++j) { v0[j] = gelu_tanh(v0[j]); v1[j] = gelu_tanh(v1[j]); } }
                if (ACT == 2) {
#pragma unroll
                    for (int j = 0; j < 4; ++j) { v0[j] = sigm(v0[j]); v1[j] = sigm(v1[j]); } }
                u32x4 w; w.x = cvt_pk_bf16(v0[0], v0[1]); w.y = cvt_pk_bf16(v0[2], v0[3]); w.z = cvt_pk_bf16(v1[0], v1[1]); w.w = cvt_pk_bf16(v1[2], v1[3]);
                *(u32x4*)(rowp + bj * 128) = w; } }
}
struct EpiPlain { static constexpr bool PERM = true, AFTER_DRAIN = false; bf16_t* O; int ld;
    __device__ __forceinline__ void operator()(const f32x4 (&acc)[2][2][4][2], const Unit& u, int wr, int wc, int fr, int fq) const {
        store_bf16_tile<0>(acc, O, ld, u.pm * 256 + wr * 64 + fr, u.pn * 256 + wc * 32 + 8 * fq); } };
struct EpiZ { static constexpr bool PERM = true, AFTER_DRAIN = false; bf16_t* Z; float* SSV;
    __device__ __forceinline__ void operator()(const f32x4 (&acc)[2][2][4][2], const Unit& u, int wr, int wc, int fr, int fq) const {
        const int row0 = u.pm * 256 + wr * 64 + fr, col0 = u.pn * 256 + wc * 32 + 8 * fq;
        if (u.pn < 2) store_bf16_tile<0>(acc, Z, DIN, row0, col0);
        else if (u.pn < 4) store_bf16_tile<1>(acc, Z, DIN, row0, col0);
        else if (u.pn < 6) {
#pragma unroll
            for (int ai = 0; ai < 2; ++ai)
#pragma unroll
                for (int m = 0; m < 4; ++m) { const size_t row = (size_t)(row0 + ai * 128 + m * 16); bf16_t* rowp = Z + row * DIN + col0; float ss = 0.f;
#pragma unroll
                    for (int bj = 0; bj < 2; ++bj) { f32x4 v0 = acc[ai][bj][m][0], v1 = acc[ai][bj][m][1];
#pragma unroll
                        for (int j = 0; j < 4; ++j) { v0[j] = gelu_tanh(v0[j]); v1[j] = gelu_tanh(v1[j]); ss += v0[j] * v0[j] + v1[j] * v1[j]; }
                        *(u32x4*)(rowp + bj * 128) = pack8(v0, v1); }
                    ss += __shfl_xor(ss, 16); ss += __shfl_xor(ss, 32);
                    if (fq == 0) SSV[row * 8 + (u.pn - 4) * 4 + wc] = ss; }
        }
        else store_bf16_tile<2>(acc, Z, DIN, row0, col0); } };
template <int MODE> struct EpiGate { static constexpr bool PERM = true, AFTER_DRAIN = false; const bf16_t* Z; bf16_t* MG; int goff;
    __device__ __forceinline__ void operator()(const f32x4 (&acc)[2][2][4][2], const Unit& u, int wr, int wc, int fr, int fq) const {
        const int row0 = u.pm * 256 + wr * 64 + fr, col0 = u.pn * 256 + wc * 32 + 8 * fq;
#pragma unroll
        for (int ai = 0; ai < 2; ++ai)
#pragma unroll
            for (int m = 0; m < 4; ++m) { const size_t row = (size_t)(row0 + ai * 128 + m * 16);
#pragma unroll
                for (int bj = 0; bj < 2; ++bj) { const int col = col0 + bj * 128;
                    const u32x4 g = *(const u32x4*)(Z + row * DIN + goff + col);
                    f32x4 v0 = acc[ai][bj][m][0], v1 = acc[ai][bj][m][1];
                    v0[0] *= bf_lo(g.x); v0[1] *= bf_hi(g.x); v0[2] *= bf_lo(g.y); v0[3] *= bf_hi(g.y);
                    v1[0] *= bf_lo(g.z); v1[1] *= bf_hi(g.z); v1[2] *= bf_lo(g.w); v1[3] *= bf_hi(g.w);
                    if (MODE == 1) { const u32x4 o = *(const u32x4*)(MG + row * DM + col);
                        v0[0] += bf_lo(o.x); v0[1] += bf_hi(o.x); v0[2] += bf_lo(o.y); v0[3] += bf_hi(o.y);
                        v1[0] += bf_lo(o.z); v1[1] += bf_hi(o.z); v1[2] += bf_lo(o.w); v1[3] += bf_hi(o.w); }
                    u32x4 w; w.x = cvt_pk_bf16(v0[0], v0[1]); w.y = cvt_pk_bf16(v0[2], v0[3]); w.z = cvt_pk_bf16(v1[0], v1[1]); w.w = cvt_pk_bf16(v1[2], v1[3]);
                    *(u32x4*)(MG + row * DM + col) = w; }
                asm volatile("" ::: "memory"); }
    } };
template <int MODE> struct EpiRes { static constexpr bool PERM = true, AFTER_DRAIN = false; const float* xp; const float* xs; float* Y; bf16_t* Xb; float* SS; float* Yout;
    __device__ __forceinline__ void operator()(const f32x4 (&acc)[2][2][4][2], const Unit& u, int wr, int wc, int fr, int fq) const {
        const int row0 = u.pm * 256 + wr * 64 + fr, col0 = u.pn * 256 + wc * 32 + 8 * fq;
        const float* base = MODE == 1 ? (const float*)Y : (u.pm < 64 ? xp : xs - (size_t)MP * DM);
#pragma unroll
        for (int ai = 0; ai < 2; ++ai)
#pragma unroll
            for (int m = 0; m < 4; ++m) { const size_t row = (size_t)(row0 + ai * 128 + m * 16); float ss = 0.f;
#pragma unroll
                for (int bj = 0; bj < 2; ++bj) { const size_t o = row * DM + col0 + bj * 128;
                    const f32x4 v0 = *(const f32x4*)(base + o) + acc[ai][bj][m][0], v1 = *(const f32x4*)(base + o + 4) + acc[ai][bj][m][1];
                    *(f32x4*)(Yout + o) = v0; *(f32x4*)(Yout + o + 4) = v1;
                    ss += (v0[0] * v0[0] + v0[1] * v0[1]) + (v0[2] * v0[2] + v0[3] * v0[3]) + (v1[0] * v1[0] + v1[1] * v1[1]) + (v1[2] * v1[2] + v1[3] * v1[3]);
                    if (MODE == 0) *(u32x4*)(Xb + o) = pack8(v0, v1); }
                ss += __shfl_xor(ss, 16); ss += __shfl_xor(ss, 32);
                if (MODE == 0 && fq == 0) SS[row * 16 + u.pn * 4 + wc] = ss;
                asm volatile("" ::: "memory"); }
    } };
struct EpiDownNorm { static constexpr bool PERM = true, AFTER_DRAIN = true; float* Y; const float* gf; float* XS; unsigned* cnt;
    __device__ __forceinline__ void operator()(const f32x4 (&)[2][2][4][2], const Unit&, int, int, int, int) const {}
    __device__ __forceinline__ void fused(const f32x4 (&acc)[2][2][4][2], const Unit& u, int wr, int wc, int fr, int fq, PG8_LAS unsigned char* lds, int wid, int lane) const {
        PG8_LAS float* P = (PG8_LAS float*)lds; PG8_LAS float* R = (PG8_LAS float*)(lds + 4096);
        const int row0 = u.pm * 256 + wr * 64 + fr, col0 = u.pn * 256 + wc * 32 + 8 * fq;
        f32x4 v[2][2][4][2];
#pragma unroll
        for (int ai = 0; ai < 2; ++ai)
#pragma unroll
            for (int m = 0; m < 4; ++m) { const size_t row = (size_t)(row0 + ai * 128 + m * 16); float ss = 0.f;
#pragma unroll
                for (int bj = 0; bj < 2; ++bj) { const size_t o = row * DM + col0 + bj * 128;
                    const f32x4 v0 = *(const f32x4*)(Y + o) + acc[ai][bj][m][0], v1 = *(const f32x4*)(Y + o + 4) + acc[ai][bj][m][1];
                    v[ai][bj][m][0] = v0; v[ai][bj][m][1] = v1;
                    ss += (v0[0] * v0[0] + v0[1] * v0[1]) + (v0[2] * v0[2] + v0[3] * v0[3]) + (v1[0] * v1[0] + v1[1] * v1[1]) + (v1[2] * v1[2] + v1[3] * v1[3]); }
                ss += __shfl_xor(ss, 16); ss += __shfl_xor(ss, 32);
                if (fq == 0) P[(ai * 128 + wr * 64 + m * 16 + fr) * 4 + wc] = ss;
                asm volatile("" ::: "memory"); }
        asm volatile("s_waitcnt lgkmcnt(0)" ::: "memory"); __builtin_amdgcn_s_barrier(); asm volatile("" ::: "memory");
        const int r = wid * 32 + (lane & 31);
        if (lane < 32) { const f32x4 q = *(const PG8_LAS f32x4*)(P + r * 4);
            __hip_atomic_store(XS + ((size_t)u.pm * 256 + r) * 4 + u.pn, (q[0] + q[1]) + (q[2] + q[3]), __ATOMIC_RELAXED, __HIP_MEMORY_SCOPE_AGENT); }
        asm volatile("s_waitcnt vmcnt(0)" ::: "memory");
        if (lane == 0) __hip_atomic_fetch_add(cnt + 64 * u.pm, 1u, __ATOMIC_RELAXED, __HIP_MEMORY_SCOPE_AGENT);
        if (wid == 0) { unsigned sp = 0u;
            while ((unsigned)__builtin_amdgcn_readfirstlane(__hip_atomic_load(cnt + 64 * u.pm, __ATOMIC_RELAXED, __HIP_MEMORY_SCOPE_AGENT)) < 32u && ++sp < (1u << 20)) __builtin_amdgcn_s_sleep(2);
            __builtin_amdgcn_fence(__ATOMIC_ACQUIRE, "agent"); asm volatile("s_waitcnt vmcnt(0)" ::: "memory"); }
        asm volatile("" ::: "memory"); __builtin_amdgcn_s_barrier(); asm volatile("" ::: "memory");
        if (lane < 32) { const float* xp = XS + ((size_t)u.pm * 256 + r) * 4;
            const float s4 = (__hip_atomic_load(xp, __ATOMIC_RELAXED, __HIP_MEMORY_SCOPE_AGENT) + __hip_atomic_load(xp + 1, __ATOMIC_RELAXED, __HIP_MEMORY_SCOPE_AGENT))
                           + (__hip_atomic_load(xp + 2, __ATOMIC_RELAXED, __HIP_MEMORY_SCOPE_AGENT) + __hip_atomic_load(xp + 3, __ATOMIC_RELAXED, __HIP_MEMORY_SCOPE_AGENT));
            R[r] = rsqrtf(s4 * (1.f / 1024.f) + EPS); }
        asm volatile("s_waitcnt lgkmcnt(0)" ::: "memory"); __builtin_amdgcn_s_barrier(); asm volatile("" ::: "memory");
        const f32x4 g00 = *(const f32x4*)(gf + col0), g01 = *(const f32x4*)(gf + col0 + 4), g10 = *(const f32x4*)(gf + col0 + 128), g11 = *(const f32x4*)(gf + col0 + 132);
#pragma unroll
        for (int ai = 0; ai < 2; ++ai)
#pragma unroll
            for (int m = 0; m < 4; ++m) { const int rl = ai * 128 + wr * 64 + m * 16 + fr; const float rr = R[rl]; float* yp = Y + (size_t)(u.pm * 256 + rl) * DM + col0;
                *(f32x4*)yp = v[ai][0][m][0] * rr * g00; *(f32x4*)(yp + 4) = v[ai][0][m][1] * rr * g01; *(f32x4*)(yp + 128) = v[ai][1][m][0] * rr * g10; *(f32x4*)(yp + 132) = v[ai][1][m][1] * rr * g11; }
    } };
struct EpiWoNorm { static constexpr bool PERM = true, AFTER_DRAIN = true; const float* xp; float* Y; bf16_t* Xb; float* XS; unsigned* cnt;
    __device__ __forceinline__ void operator()(const f32x4 (&)[2][2][4][2], const Unit&, int, int, int, int) const {}
    __device__ __forceinline__ void fused(const f32x4 (&acc)[2][2][4][2], const Unit& u, int wr, int wc, int fr, int fq, PG8_LAS unsigned char* lds, int wid, int lane) const {
        PG8_LAS float* P = (PG8_LAS float*)lds; PG8_LAS float* R = (PG8_LAS float*)(lds + 4096);
        const int row0 = u.pm * 256 + wr * 64 + fr, col0 = u.pn * 256 + wc * 32 + 8 * fq;
        f32x4 v[2][2][4][2];
#pragma unroll
        for (int ai = 0; ai < 2; ++ai)
#pragma unroll
            for (int m = 0; m < 4; ++m) { const size_t row = (size_t)(row0 + ai * 128 + m * 16); float ss = 0.f;
#pragma unroll
                for (int bj = 0; bj < 2; ++bj) { const size_t o = row * DM + col0 + bj * 128;
                    const f32x4 v0 = *(const f32x4*)(xp + o) + acc[ai][bj][m][0], v1 = *(const f32x4*)(xp + o + 4) + acc[ai][bj][m][1];
                    *(f32x4*)(Y + o) = v0; *(f32x4*)(Y + o + 4) = v1; v[ai][bj][m][0] = v0; v[ai][bj][m][1] = v1;
                    ss += (v0[0] * v0[0] + v0[1] * v0[1]) + (v0[2] * v0[2] + v0[3] * v0[3]) + (v1[0] * v1[0] + v1[1] * v1[1]) + (v1[2] * v1[2] + v1[3] * v1[3]); }
                ss += __shfl_xor(ss, 16); ss += __shfl_xor(ss, 32);
                if (fq == 0) P[(ai * 128 + wr * 64 + m * 16 + fr) * 4 + wc] = ss;
                asm volatile("" ::: "memory"); }
        asm volatile("s_waitcnt lgkmcnt(0)" ::: "memory"); __builtin_amdgcn_s_barrier(); asm volatile("" ::: "memory");
        const int r = wid * 32 + (lane & 31);
        if (lane < 32) { const f32x4 q = *(const PG8_LAS f32x4*)(P + r * 4);
            __hip_atomic_store(XS + ((size_t)u.pm * 256 + r) * 4 + u.pn, (q[0] + q[1]) + (q[2] + q[3]), __ATOMIC_RELAXED, __HIP_MEMORY_SCOPE_AGENT); }
        asm volatile("s_waitcnt vmcnt(0)" ::: "memory");
        if (lane == 0) __hip_atomic_fetch_add(cnt + 64 * u.pm, 1u, __ATOMIC_RELAXED, __HIP_MEMORY_SCOPE_AGENT);
        if (wid == 0) { unsigned sp = 0u;
            while ((unsigned)__builtin_amdgcn_readfirstlane(__hip_atomic_load(cnt + 64 * u.pm, __ATOMIC_RELAXED, __HIP_MEMORY_SCOPE_AGENT)) < 32u && ++sp < (1u << 20)) __builtin_amdgcn_s_sleep(2);
            __builtin_amdgcn_fence(__ATOMIC_ACQUIRE, "agent"); asm volatile("s_waitcnt vmcnt(0)" ::: "memory"); }
        asm volatile("" ::: "memory"); __builtin_amdgcn_s_barrier(); asm volatile("" ::: "memory");
        if (lane < 32) { const float* xq = XS + ((size_t)u.pm * 256 + r) * 4;
            const float s4 = (__hip_atomic_load(xq, __ATOMIC_RELAXED, __HIP_MEMORY_SCOPE_AGENT) + __hip_atomic_load(xq + 1, __ATOMIC_RELAXED, __HIP_MEMORY_SCOPE_AGENT))
                           + (__hip_atomic_load(xq + 2, __ATOMIC_RELAXED, __HIP_MEMORY_SCOPE_AGENT) + __hip_atomic_load(xq + 3, __ATOMIC_RELAXED, __HIP_MEMORY_SCOPE_AGENT));
            R[r] = rsqrtf(s4 * (1.f / 1024.f) + EPS); }
        asm volatile("s_waitcnt lgkmcnt(0)" ::: "memory"); __builtin_amdgcn_s_barrier(); asm volatile("" ::: "memory");
#pragma unroll
        for (int ai = 0; ai < 2; ++ai)
#pragma unroll
            for (int m = 0; m < 4; ++m) { const int rl = ai * 128 + wr * 64 + m * 16 + fr; const float rr = R[rl]; bf16_t* bp = Xb + (size_t)(u.pm * 256 + rl) * DM + col0;
                *(u32x4*)bp = pack8(v[ai][0][m][0] * rr, v[ai][0][m][1] * rr); *(u32x4*)(bp + 128) = pack8(v[ai][1][m][0] * rr, v[ai][1][m][1] * rr); }
    } };
struct EpiPartial { static constexpr bool PERM = true, AFTER_DRAIN = false; float* P; int kext;
    __device__ __forceinline__ void operator()(const f32x4 (&acc)[2][2][4][2], const Unit& u, int wr, int wc, int fr, int fq) const {
        const int row0 = u.pm * 256 + wr * 64 + fr, col0 = u.pn * 256 + wc * 32 + 8 * fq; float* base = P + (size_t)(u.ko / kext) * ((size_t)(MT - MP) * DM);
#pragma unroll
        for (int ai = 0; ai < 2; ++ai)
#pragma unroll
            for (int m = 0; m < 4; ++m) { float* rowp = base + (size_t)(row0 + ai * 128 + m * 16) * DM + col0;
#pragma unroll
                for (int bj = 0; bj < 2; ++bj) { *(f32x4*)(rowp + bj * 128) = acc[ai][bj][m][0]; *(f32x4*)(rowp + bj * 128 + 4) = acc[ai][bj][m][1]; } }
    } };
struct EpiUG { static constexpr bool PERM = true, AFTER_DRAIN = false; const float* SS; bf16_t* A2; bf16_t* G2;
    __device__ __forceinline__ void operator()(const f32x4 (&acc)[2][2][4][2], const Unit& u, int wr, int wc, int fr, int fq) const {
        const int row0 = u.pm * 256 + wr * 64 + fr, ch0 = u.pn * 128 + wc * 32 + 8 * fq;
#pragma unroll
        for (int ai = 0; ai < 2; ++ai)
#pragma unroll
            for (int m = 0; m < 4; ++m) { const size_t row = (size_t)(row0 + ai * 128 + m * 16);
                const f32x4 s0 = *(const f32x4*)(SS + row * 16), s1 = *(const f32x4*)(SS + row * 16 + 4), s2 = *(const f32x4*)(SS + row * 16 + 8), s3 = *(const f32x4*)(SS + row * 16 + 12);
                const f32x4 st = (s0 + s1) + (s2 + s3); const float r = rsqrtf(((st[0] + st[1]) + (st[2] + st[3])) * (1.f / 1024.f) + EPS);
#pragma unroll
                for (int bj = 0; bj < 2; ++bj) { const f32x4 v0 = acc[ai][bj][m][0] * r, v1 = acc[ai][bj][m][1] * r;
                    u32x4 w; w.x = cvt_pk_bf16(v0[0], v0[1]); w.y = cvt_pk_bf16(v0[2], v0[3]); w.z = cvt_pk_bf16(v1[0], v1[1]); w.w = cvt_pk_bf16(v1[2], v1[3]);
                    *(u32x4*)((bj ? G2 : A2) + row * DFF + ch0) = w; }
                asm volatile("" ::: "memory"); }
    } };


__device__ __forceinline__ float rms_of(const float* SS, int row) { const float* sp = SS + (size_t)row * 16;
    const f32x4 st = (*(const f32x4*)sp + *(const f32x4*)(sp + 4)) + (*(const f32x4*)(sp + 8) + *(const f32x4*)(sp + 12)); return rsqrtf(((st[0] + st[1]) + (st[2] + st[3])) * (1.f / 1024.f) + EPS); }
template <int CTRL> __device__ __forceinline__ float dpp_f(float v) { const int x = __builtin_bit_cast(int, v); return __builtin_bit_cast(float, __builtin_amdgcn_update_dpp(x, x, CTRL, 0xf, 0xf, false)); }
struct EpiUGConv { static constexpr bool PERM = true, AFTER_DRAIN = false;
    const float* SS; bf16_t* F; float* EA; float* EG; const float* cw; const float* cb; const float* sc; float* out; PG8_LAS float* halo; int prenorm;
    __device__ __forceinline__ void operator()(const f32x4 (&acc)[2][2][4][2], const Unit& u, int wr, int wc, int fr, int fq) const {
        const int ch0 = u.pn * 128 + wc * 32 + 8 * fq, rowt = u.pm * 256 + wr * 64 + fr; const bool smp = u.pm >= 64;
        const f32x4 w0a = *(const f32x4*)(cw + ch0), w0b = *(const f32x4*)(cw + ch0 + 4), w1a = *(const f32x4*)(cw + DFF + ch0), w1b = *(const f32x4*)(cw + DFF + ch0 + 4);
        const f32x4 w2a = *(const f32x4*)(cw + 2 * DFF + ch0), w2b = *(const f32x4*)(cw + 2 * DFF + ch0 + 4), ba = *(const f32x4*)(cb + ch0), bb = *(const f32x4*)(cb + ch0 + 4);
        const f32x4 z4 = (f32x4){0.f, 0.f, 0.f, 0.f};
        if (!smp) {
            if (fr >= 14) {
#pragma unroll
                for (int ai = 0; ai < 2; ++ai) { const float r3 = prenorm ? 1.f : rms_of(SS, rowt + ai * 128 + 48);
                    PG8_LAS float* hp = halo + (((2 * ai + wr) * 4 + wc) * 2 + (fr - 14)) * 32 + fq * 8;
                    *(PG8_LAS f32x4*)hp = acc[ai][0][3][0] * r3; *(PG8_LAS f32x4*)(hp + 4) = acc[ai][0][3][1] * r3; } }
            asm volatile("s_waitcnt lgkmcnt(0)" ::: "memory"); __builtin_amdgcn_s_barrier(); asm volatile("" ::: "memory"); __builtin_amdgcn_s_barrier(); asm volatile("" ::: "memory");
        }
#pragma unroll
        for (int ai = 0; ai < 2; ++ai) { float rprev = 0.f;
#pragma unroll
            for (int m = 0; m < 4; ++m) {
                const int rowi = rowt + ai * 128 + m * 16; const size_t row = (size_t)rowi; const float rc = (prenorm && !smp) ? 1.f : rms_of(SS, rowi);
                const f32x4 ca = acc[ai][0][m][0] * rc, cbv = acc[ai][0][m][1] * rc, ga = acc[ai][1][m][0] * rc, gb = acc[ai][1][m][1] * rc;
                f32x4 pa = z4, pb = z4;
                if (m > 0) { pa = acc[ai][0][m > 0 ? m - 1 : 0][0] * rprev; pb = acc[ai][0][m > 0 ? m - 1 : 0][1] * rprev; }
                else if (!smp && 2 * ai + wr >= 1) { const PG8_LAS float* hp = halo + ((((2 * ai + wr - 1) * 4 + wc) * 2 + (fr == 15 ? 1 : 0)) * 32) + fq * 8; pa = *(const PG8_LAS f32x4*)hp; pb = *(const PG8_LAS f32x4*)(hp + 4); }
                rprev = rc;
                f32x4 p1a, p1b, p2a, p2b;
#pragma unroll
                for (int k = 0; k < 4; ++k) {
                    p1a[k] = dpp_f<0x121>(fr == 15 ? pa[k] : ca[k]); p1b[k] = dpp_f<0x121>(fr == 15 ? pb[k] : cbv[k]);
                    p2a[k] = dpp_f<0x122>(fr >= 14 ? pa[k] : ca[k]); p2b[k] = dpp_f<0x122>(fr >= 14 ? pb[k] : cbv[k]); }
                if (smp) { const int t = fr & 7, db = (rowi - MP) >> 3;
                    if (t < 2) { const float* s0 = sc + (size_t)db * 2 * DFF + ch0; const f32x4 s0a = *(const f32x4*)s0, s0b = *(const f32x4*)(s0 + 4), s1a = *(const f32x4*)(s0 + DFF), s1b = *(const f32x4*)(s0 + DFF + 4);
                        if (t == 0) { p1a = s1a; p1b = s1b; p2a = s0a; p2b = s0b; } else { p2a = s1a; p2b = s1b; } }
                    if (t >= 6) { float* q = out + O_NCS + ((size_t)db * 2 + (t - 6)) * DFF + ch0; *(f32x4*)q = ca; *(f32x4*)(q + 4) = cbv; } }
                else {
                    if (ai == 0 && m == 0 && wr == 0 && fr < 2) { float* q = EA + ((size_t)u.pm * 4 + fr) * DFF + ch0; *(f32x4*)q = ca; *(f32x4*)(q + 4) = cbv; float* q2 = EG + ((size_t)u.pm * 2 + fr) * DFF + ch0; *(f32x4*)q2 = ga; *(f32x4*)(q2 + 4) = gb; }
                    if (ai == 1 && m == 3 && wr == 1 && fr >= 14) { float* q = EA + ((size_t)u.pm * 4 + 2 + (fr - 14)) * DFF + ch0; *(f32x4*)q = ca; *(f32x4*)(q + 4) = cbv;
                        if ((u.pm & 7) == 7) { float* q2 = out + O_NCP + ((size_t)(u.pm >> 3) * 2 + (fr - 14)) * DFF + ch0; *(f32x4*)q2 = ca; *(f32x4*)(q2 + 4) = cbv; } } }
                const f32x4 xa = w0a * p2a + w1a * p1a + w2a * ca + ba, xb = w0b * p2b + w1b * p1b + w2b * cbv + bb;
                f32x4 fa, fb;
#pragma unroll
                for (int k = 0; k < 4; ++k) { fa[k] = gelu_tanh(xa[k]) * ga[k]; fb[k] = gelu_tanh(xb[k]) * gb[k]; }
                *(u32x4*)(F + row * DFF + ch0) = pack8(fa, fb);
                if (m == 3) asm volatile("" ::: "memory"); } }
    } };
__device__ __forceinline__ void p6_fix(const Params& p, int pm) {
    const float* EA = (const float*)(p.ws + OFF_EA); const float* EG = (const float*)(p.ws + OFF_EG); bf16_t* F = (bf16_t*)(p.ws + OFF_G2); const float* cw = p.in[I_CW]; const float* cb = p.in[I_CB];
    for (int it = threadIdx.x; it < 704; it += 512) { const int r01 = it >= 352 ? 1 : 0, ch = (it - r01 * 352) * 8;
        const float* e2 = EA + ((size_t)(pm - 1) * 4 + 2 + r01) * DFF + ch;
        const float* e1 = r01 ? EA + ((size_t)pm * 4 + 0) * DFF + ch : EA + ((size_t)(pm - 1) * 4 + 3) * DFF + ch;
        const float* e0 = EA + ((size_t)pm * 4 + r01) * DFF + ch; const float* gg = EG + ((size_t)pm * 2 + r01) * DFF + ch;
        f32x4 fa, fb;
#pragma unroll
        for (int hf = 0; hf < 2; ++hf) { const int o = hf * 4; const f32x4 x = *(const f32x4*)(cw + ch + o) * *(const f32x4*)(e2 + o) + *(const f32x4*)(cw + DFF + ch + o) * *(const f32x4*)(e1 + o) + *(const f32x4*)(cw + 2 * DFF + ch + o) * *(const f32x4*)(e0 + o) + *(const f32x4*)(cb + ch + o);
            const f32x4 g = *(const f32x4*)(gg + o); f32x4 f;
#pragma unroll
            for (int k = 0; k < 4; ++k) f[k] = gelu_tanh(x[k]) * g[k];
            if (hf) fb = f; else fa = f; }
        *(u32x4*)(F + ((size_t)pm * 256 + r01) * DFF + ch) = pack8(fa, fb); }
    asm volatile("s_waitcnt vmcnt(0)" ::: "memory"); __syncthreads();
}


__device__ __forceinline__ void small_mma(const bf16_t* A, int lda, const bf16_t* Bt, int ldb, int K, int arow, int bcol, int fq, f32x4 (&acc)[2]) {
    const bf16_t* ap = A + (size_t)arow * lda + fq * 8; const bf16_t* b0 = Bt + (size_t)bcol * ldb + fq * 8; const bf16_t* b1 = b0 + (size_t)16 * ldb;
    for (int k0 = 0; k0 < K; k0 += 256) {
        bf16x8 a[8], x[8], y[8];
#pragma unroll
        for (int u = 0; u < 8; ++u) { a[u] = *(const bf16x8*)(ap + k0 + u * 32); x[u] = *(const bf16x8*)(b0 + k0 + u * 32); y[u] = *(const bf16x8*)(b1 + k0 + u * 32); }
#pragma unroll
        for (int u = 0; u < 8; ++u) { acc[0] = __builtin_amdgcn_mfma_f32_16x16x32_bf16(x[u], a[u], acc[0], 0, 0, 0); acc[1] = __builtin_amdgcn_mfma_f32_16x16x32_bf16(y[u], a[u], acc[1], 0, 0, 0); }
    }
}
__device__ __forceinline__ void small_ab(const Params& p) {
    unsigned char* ws = p.ws; const int tid = threadIdx.x, lane = tid & 63, w = tid >> 6, fr = lane & 15, fq = lane >> 4;
    const bf16_t* Z = (const bf16_t*)(ws + OFF_Z); bf16_t* MG = (bf16_t*)(ws + OFF_MG);
    for (int t = blockIdx.x; t < 256; t += gridDim.x) { const int tm = t >> 4, tn = t & 15, arow = MP + tm * 64 + (w & 3) * 16 + fr, cb = tn * 64 + (w >> 2) * 32;
        f32x4 aa[2] = {(f32x4){0.f, 0.f, 0.f, 0.f}, (f32x4){0.f, 0.f, 0.f, 0.f}}, ab[2] = {(f32x4){0.f, 0.f, 0.f, 0.f}, (f32x4){0.f, 0.f, 0.f, 0.f}};
        small_mma((const bf16_t*)(ws + OFF_D), 512, (const bf16_t*)(ws + OFF_WEFF), 512, 512, arow, cb + fr, fq, aa);
        small_mma((const bf16_t*)(ws + OFF_S), 512, (const bf16_t*)(ws + OFF_WSO), 512, 512, arow, cb + fr, fq, ab);
#pragma unroll
        for (int t2 = 0; t2 < 2; ++t2) { const int col = cb + t2 * 16 + fq * 4; const u32x2 ga = *(const u32x2*)(Z + (size_t)arow * DIN + 1536 + col), gb = *(const u32x2*)(Z + (size_t)arow * DIN + 2560 + col);
            u32x2 o; o.x = cvt_pk_bf16(bf_lo(ga.x) * aa[t2][0] + bf_lo(gb.x) * ab[t2][0], bf_hi(ga.x) * aa[t2][1] + bf_hi(gb.x) * ab[t2][1]);
            o.y = cvt_pk_bf16(bf_lo(ga.y) * aa[t2][2] + bf_lo(gb.y) * ab[t2][2], bf_hi(ga.y) * aa[t2][3] + bf_hi(gb.y) * ab[t2][3]);
            *(u32x2*)(MG + (size_t)arow * DM + col) = o; } }
}
__device__ __forceinline__ void small_o(const Params& p, unsigned char* lds) {
    unsigned char* ws = p.ws; const int tid = threadIdx.x, lane = tid & 63, w = tid >> 6, fr = lane & 15, fq = lane >> 4;
    float* Y = p.out + O_Y; bf16_t* Xb = (bf16_t*)(ws + OFF_R1); float* SS = (float*)(ws + OFF_SS); float* red = (float*)lds; const float* xs = p.in[I_XS];
    for (int t = blockIdx.x; t < 256; t += gridDim.x) { const int tm = t >> 4, tn = t & 15, arow = MP + tm * 64 + (w & 3) * 16 + fr, cb = tn * 64 + (w >> 2) * 32;
        f32x4 acc[2] = {(f32x4){0.f, 0.f, 0.f, 0.f}, (f32x4){0.f, 0.f, 0.f, 0.f}};
        small_mma((const bf16_t*)(ws + OFF_MG), 1024, (const bf16_t*)(ws + OFF_WO), 1024, 1024, arow, cb + fr, fq, acc);
        float ss = 0.f;
#pragma unroll
        for (int t2 = 0; t2 < 2; ++t2) { const int col = cb + t2 * 16 + fq * 4; const f32x4 v = *(const f32x4*)(xs + (size_t)(arow - MP) * DM + col) + acc[t2];
            *(f32x4*)(Y + (size_t)arow * DM + col) = v; ss += (v[0] * v[0] + v[1] * v[1]) + (v[2] * v[2] + v[3] * v[3]);
            u32x2 o; o.x = cvt_pk_bf16(v[0], v[1]); o.y = cvt_pk_bf16(v[2], v[3]); *(u32x2*)(Xb + (size_t)arow * DM + col) = o; }
        ss += __shfl_xor(ss, 16); ss += __shfl_xor(ss, 32);
        if (fq == 0) red[w * 16 + fr] = ss;
        __syncthreads();
        if (w < 4 && fq == 0) SS[(size_t)arow * 16 + tn] = red[w * 16 + fr] + red[(w + 4) * 16 + fr];
        __syncthreads(); }
}

template <int W> __device__ __forceinline__ void pool_wave(const Params& p, int rq, int h, int lane) {
    const bf16_t* Z = (const bf16_t*)(p.ws + OFF_Z); bf16_t* Dd = (bf16_t*)(p.ws + OFF_D); const float* spool = p.in[I_SPOOL]; float* out = p.out;
    const int run = lane >> 4, cgi = lane & 15, row0 = rq * 32 + run * 8, c0 = h * 128 + cgi * 8;
    const bool smp = row0 >= MP; const int pos0 = row0 & 2047, db = (row0 - MP) >> 3;
    u32x4 ext[W - 1 + 8];
#pragma unroll
    for (int i = 0; i < 8; ++i) ext[W - 1 + i] = *(const u32x4*)(Z + (size_t)(row0 + i) * DIN + c0);
    if (!smp) {
#pragma unroll
        for (int k = 1; k < W; ++k) { const bool ok = pos0 - k >= 0; const u32x4 q = *(const u32x4*)(Z + (size_t)(ok ? row0 - k : row0) * DIN + c0); ext[W - 1 - k] = ok ? q : (u32x4){0u, 0u, 0u, 0u}; }
    } else {
#pragma unroll
        for (int k = 1; k < W; ++k) { const float* sp = spool + ((size_t)db * 15 + 15 - k) * 512 + c0; ext[W - 1 - k] = pack8(*(const f32x4*)sp, *(const f32x4*)(sp + 4)); }
    }
    f32x4 s0 = (f32x4){0.f, 0.f, 0.f, 0.f}, s1 = s0;
#pragma unroll
    for (int j = 0; j < W; ++j) { f32x4 a, b; unpack8(ext[j], a, b); s0 += a; s1 += b; }
#pragma unroll
    for (int i = 0; i < 8; ++i) {
        f32x4 ca, cb; unpack8(ext[W - 1 + i], ca, cb);
        const int t = pos0 + i; const int cnt = smp ? W : (W < t + 1 ? W : t + 1); const float inv = 1.f / (float)cnt;
        *(u32x4*)(Dd + (size_t)(row0 + i) * 512 + c0) = pack8(s0 * inv - ca, s1 * inv - cb);
        if (smp) { float* o = out + O_NPS + ((size_t)db * 15 + 7 + i) * 512 + c0; *(f32x4*)o = ca; *(f32x4*)(o + 4) = cb; }
        else if (t >= 2033) { float* o = out + O_NPP + ((size_t)(row0 >> 11) * 15 + (t - 2033)) * 512 + c0; *(f32x4*)o = ca; *(f32x4*)(o + 4) = cb; }
        if (i < 7) { f32x4 na, nb, oa, ob; unpack8(ext[W + i], na, nb); unpack8(ext[i], oa, ob); s0 += na - oa; s1 += nb - ob; }
    }
    if (smp && h == 0) {
#pragma unroll
        for (int j = 0; j < 7; ++j)
#pragma unroll
            for (int g = 0; g < 4; ++g) { const float* sp = spool + ((size_t)db * 15 + 8 + j) * 512 + g * 128 + cgi * 8; float* o = out + O_NPS + ((size_t)db * 15 + j) * 512 + g * 128 + cgi * 8;
                *(f32x4*)o = *(const f32x4*)sp; *(f32x4*)(o + 4) = *(const f32x4*)(sp + 4); }
    }
}
__device__ __forceinline__ void p2_mixer(const Params& p, unsigned char* lds) {
    unsigned char* ws = p.ws; const int tid = threadIdx.x, lane = tid & 63, wave = tid >> 6, fr = lane & 15, fq = lane >> 4;
    const bf16_t* Z = (const bf16_t*)(ws + OFF_Z); bf16_t* Sd = (bf16_t*)(ws + OFF_S); const float* SSV = (const float*)(ws + OFF_SS);
    bf16_t* Vt = (bf16_t*)lds; float* rs = (float*)(lds + 34816);
    const float* sng = p.in[I_SNG]; const float* sgub = p.in[I_SGUB];
    float* out = p.out;
    { const int sp = tid >> 3, dq = tid & 7, d0 = dq * 16, tl = 16 * wave + fr;
      u32x4 q00, q01, q10, q11; u32x2 uu[8], un[8]; float bias = 0.f, biasn = 0.f; int par = 0;
#define SGU_LOAD(IT, UU, BIAS, RSB) do { const int ci_ = (IT) >> 2, h_ = (IT) & 3, base_ = ci_ * 128; const bool smp_ = ci_ >= 128; \
        if (tid < 128) { const f32x4 a_ = *(const f32x4*)(SSV + (size_t)(base_ + tid) * 8), b_ = *(const f32x4*)(SSV + (size_t)(base_ + tid) * 8 + 4); \
            (RSB)[tid] = rsqrtf(((a_[0] + a_[1]) + (a_[2] + a_[3]) + (b_[0] + b_[1]) + (b_[2] + b_[3])) * (1.f / 512.f) + EPS); } \
        const bf16_t* zr_ = Z + (size_t)(base_ + 2 * sp) * DIN + 1024 + h_ * 128 + d0; \
        q00 = *(const u32x4*)zr_; q01 = *(const u32x4*)(zr_ + 8); q10 = *(const u32x4*)(zr_ + DIN); q11 = *(const u32x4*)(zr_ + DIN + 8); \
        _Pragma("unroll") for (int n = 0; n < 8; ++n) (UU)[n] = *(const u32x2*)(Z + (size_t)(base_ + tl) * DIN + 512 + h_ * 128 + n * 16 + fq * 4); \
        (BIAS) = sgub[h_ * 128 + (smp_ ? (tl & 7) : tl)]; } while (0)
      if ((int)blockIdx.x < 136 * 4) SGU_LOAD((int)blockIdx.x, uu, bias, rs);
    for (int wi = ((int)gridDim.x - 1 - (int)blockIdx.x) * 8 + wave; wi < (MT / 32) * 4; wi += gridDim.x * 8) { const int h = wi & 3, rq = wi >> 2;
        if (h == 0) pool_wave<2>(p, rq, 0, lane); else if (h == 1) pool_wave<4>(p, rq, 1, lane); else if (h == 2) pool_wave<8>(p, rq, 2, lane); else pool_wave<16>(p, rq, 3, lane); }
      for (int it = blockIdx.x; it < 136 * 4; it += gridDim.x, par ^= 1) {
        const int ci = it >> 2, h = it & 3, base = ci * 128; const bool smp = ci >= 128; const float* rsb = rs + par * 128;
        __syncthreads();
        { const size_t row = (size_t)(base + 2 * sp); const float r0 = rsb[2 * sp], r1 = rsb[2 * sp + 1];
#pragma unroll
          for (int hf = 0; hf < 2; ++hf) { const int dd = d0 + hf * 8; const f32x4 g0 = *(const f32x4*)(sng + h * 128 + dd), g1 = *(const f32x4*)(sng + h * 128 + dd + 4);
              f32x4 a0, a1, b0, b1; unpack8(hf ? q01 : q00, a0, a1); unpack8(hf ? q11 : q10, b0, b1);
              a0 = a0 * r0 * g0; a1 = a1 * r0 * g1; b0 = b0 * r1 * g0; b1 = b1 * r1 * g1;
#pragma unroll
              for (int j = 0; j < 4; ++j) { *(unsigned*)(Vt + (dd + j) * 136 + 2 * sp) = cvt_pk_bf16(a0[j], b0[j]); *(unsigned*)(Vt + (dd + 4 + j) * 136 + 2 * sp) = cvt_pk_bf16(a1[j], b1[j]); }
              if (smp) { float* o = out + O_NV + (row - MP) * 512 + h * 128 + dd; *(f32x4*)o = a0; *(f32x4*)(o + 4) = a1; *(f32x4*)(o + 512) = b0; *(f32x4*)(o + 516) = b1; } } }
        __syncthreads();
        const int itn = it + (int)gridDim.x;
        if (itn < 136 * 4) SGU_LOAD(itn, un, biasn, rs + (par ^ 1) * 128);
        { const bf16_t* Wm = (const bf16_t*)(ws + (smp ? OFF_WMS : OFF_WMP)) + h * 16384; const size_t erow = (size_t)(base + tl);
          f32x4 acc[8];
#pragma unroll
          for (int n = 0; n < 8; ++n) acc[n] = (f32x4){0.f, 0.f, 0.f, 0.f};
          const int nk = (16 * wave + 15) / 32 + 1;
          for (int kk = 0; kk < nk; ++kk) { const bf16x8 wf = *(const bf16x8*)(Wm + (16 * wave + fr) * 128 + kk * 32 + fq * 8);
#pragma unroll
              for (int n = 0; n < 8; ++n) { const bf16x8 vf = *(const bf16x8*)(Vt + (n * 16 + fr) * 136 + kk * 32 + fq * 8);
                  acc[n] = __builtin_amdgcn_mfma_f32_16x16x32_bf16(vf, wf, acc[n], 0, 0, 0); } }
#pragma unroll
          for (int n = 0; n < 8; ++n) { const int col = h * 128 + n * 16 + fq * 4;
              u32x2 w; w.x = cvt_pk_bf16(bf_lo(uu[n].x) * (acc[n][0] + bias), bf_hi(uu[n].x) * (acc[n][1] + bias)); w.y = cvt_pk_bf16(bf_lo(uu[n].y) * (acc[n][2] + bias), bf_hi(uu[n].y) * (acc[n][3] + bias));
              *(u32x2*)(Sd + erow * 512 + col) = w; } }
#pragma unroll
        for (int n = 0; n < 8; ++n) uu[n] = un[n];
        bias = biasn;
      }
#undef SGU_LOAD
    }
}

__device__ __forceinline__ void p6_conv(const Params& p) {
    unsigned char* ws = p.ws; const bf16_t* A2 = (const bf16_t*)(ws + OFF_A2); bf16_t* G2 = (bf16_t*)(ws + OFF_G2);
    const float* cw = p.in[I_CW]; const float* cb = p.in[I_CB]; const float* sc = p.in[I_SCONV]; float* out = p.out;
    const int total = (MT / 8) * 352;
    for (int it = blockIdx.x * 512 + threadIdx.x; it < total; it += gridDim.x * 512) {
        const int rg = it / 352, ch = (it - rg * 352) * 8, row0 = rg * 8;
        const f32x4 w0a = *(const f32x4*)(cw + ch), w0b = *(const f32x4*)(cw + ch + 4), w1a = *(const f32x4*)(cw + DFF + ch), w1b = *(const f32x4*)(cw + DFF + ch + 4);
        const f32x4 w2a = *(const f32x4*)(cw + 2 * DFF + ch), w2b = *(const f32x4*)(cw + 2 * DFF + ch + 4), ba = *(const f32x4*)(cb + ch), bb = *(const f32x4*)(cb + ch + 4);
        f32x4 p2a = (f32x4){0.f, 0.f, 0.f, 0.f}, p2b = p2a, p1a = p2a, p1b = p2a;
        const bool smp = row0 >= MP; const int db = (row0 - MP) >> 3;
        if (smp) { const float* s = sc + (size_t)db * 2 * DFF + ch; p2a = *(const f32x4*)s; p2b = *(const f32x4*)(s + 4); p1a = *(const f32x4*)(s + DFF); p1b = *(const f32x4*)(s + DFF + 4); }
        else if (row0 & 2047) { unpack8(*(const u32x4*)(A2 + (size_t)(row0 - 2) * DFF + ch), p2a, p2b); unpack8(*(const u32x4*)(A2 + (size_t)(row0 - 1) * DFF + ch), p1a, p1b); }
#pragma unroll
        for (int i = 0; i < 8; ++i) { const size_t o = (size_t)(row0 + i) * DFF + ch; f32x4 ca, cbv, ga, gb; unpack8(*(const u32x4*)(A2 + o), ca, cbv); unpack8(*(const u32x4*)(G2 + o), ga, gb);
            const f32x4 xa = w0a * p2a + w1a * p1a + w2a * ca + ba, xb = w0b * p2b + w1b * p1b + w2b * cbv + bb;
            u32x4 w; w.x = cvt_pk_bf16(gelu_tanh(xa[0]) * ga[0], gelu_tanh(xa[1]) * ga[1]); w.y = cvt_pk_bf16(gelu_tanh(xa[2]) * ga[2], gelu_tanh(xa[3]) * ga[3]);
            w.z = cvt_pk_bf16(gelu_tanh(xb[0]) * gb[0], gelu_tanh(xb[1]) * gb[1]); w.w = cvt_pk_bf16(gelu_tanh(xb[2]) * gb[2], gelu_tanh(xb[3]) * gb[3]);
            *(u32x4*)(G2 + o) = w;
            if (i >= 6) { if (smp) { float* q = out + O_NCS + ((size_t)db * 2 + (i - 6)) * DFF + ch; *(f32x4*)q = ca; *(f32x4*)(q + 4) = cbv; }
                          else if ((row0 & 2047) == 2040) { float* q = out + O_NCP + ((size_t)(row0 >> 11) * 2 + (i - 6)) * DFF + ch; *(f32x4*)q = ca; *(f32x4*)(q + 4) = cbv; } }
            p2a = p1a; p2b = p1b; p1a = ca; p1b = cbv; }
    }
}

__device__ __forceinline__ void p8_final(const Params& p, float* Yo, int rg0) {
    const int lane = threadIdx.x & 63, wave = threadIdx.x >> 6; const float* gf = p.in[I_FNG]; float* Y = p.out + O_Y;
    for (int rg = rg0 + blockIdx.x; rg < MT / 8; rg += gridDim.x) { const size_t row = (size_t)(rg * 8 + wave);
        f32x4 v[4]; float ss = 0.f;
#pragma unroll
        for (int i = 0; i < 4; ++i) { v[i] = *(const f32x4*)(Y + row * DM + i * 256 + lane * 4);
            if (row >= MP) { const float* pp = (const float*)(p.ws + OFF_A2) + (row - MP) * DM + i * 256 + lane * 4;
#pragma unroll
                for (int ks = 0; ks < 11; ++ks) v[i] += *(const f32x4*)(pp + (size_t)ks * ((size_t)(MT - MP) * DM)); }
            ss += v[i][0] * v[i][0] + v[i][1] * v[i][1] + v[i][2] * v[i][2] + v[i][3] * v[i][3]; }
        ss = wave_sum(ss); const float r = rsqrtf(ss * (1.f / 1024.f) + EPS);
#pragma unroll
        for (int i = 0; i < 4; ++i) { const f32x4 g = *(const f32x4*)(gf + i * 256 + lane * 4); *(f32x4*)(Yo + row * DM + i * 256 + lane * 4) = v[i] * r * g; } }
}

struct SampleOrder : pg8::StaticOrder {
    __device__ bool next(int i, Unit& u) const { if (c < 0) return false; if (!pg8::StaticOrder::next(i, u)) return false; u.pm += 64; return true; }
};
#define XB_TMO      128
#define XB_XCNT(j)  (256  + 64 * (j))
#define XB_XSUB(j)  (1280 + 64 * (j))
#define XB_XGEN(j)  (2304 + 64 * (j))
#define XB_TOP      3328
#define XB_TOPGEN   3392
#define XCD_BAR_WORDS 3456
#define XB_SPIN_CAP (1u << 18)
#define LAS __attribute__((address_space(3)))

__device__ __forceinline__ unsigned xb_ld(unsigned* p)              { return __hip_atomic_load(p, __ATOMIC_RELAXED, __HIP_MEMORY_SCOPE_AGENT); }
__device__ __forceinline__ unsigned xb_add(unsigned* p, unsigned v) { return __hip_atomic_fetch_add(p, v, __ATOMIC_RELAXED, __HIP_MEMORY_SCOPE_AGENT); }
__device__ __forceinline__ unsigned xb_xcc_id() { return (unsigned)__builtin_amdgcn_s_getreg((3 << 11) | 20) & 0xFu; }
#define XB_SPIN(cond, bar) do { unsigned _sp = 0; while (cond) { __builtin_amdgcn_s_sleep(1); \
    if ((++_sp & 255u) == 0u) { if (xb_ld(&(bar)[XB_TMO])) break; if (_sp > XB_SPIN_CAP) { atomicAdd(&(bar)[XB_TMO], 1u); break; } } } } while (0)

struct XcdBarrier {
    unsigned* bar; unsigned x;
    volatile LAS unsigned* st;
};

__device__ __forceinline__ XcdBarrier xcd_barrier_post(unsigned* bar, volatile LAS unsigned* st) {
    XcdBarrier b; b.bar = bar; b.x = xb_xcc_id(); b.st = st;
    if (threadIdx.x == 0) (void)xb_add(&bar[XB_XCNT(b.x)], 1u);
    return b;
}
__device__ __forceinline__ void xcd_barrier_complete(unsigned* bar, unsigned x, unsigned& nloc, unsigned& nx) {
    const unsigned G = gridDim.x * gridDim.y * gridDim.z;
    unsigned sum, cnt, mine, sp = 0u;
    for (;;) {
        sum = 0u; cnt = 0u; mine = 0u;
#pragma unroll
        for (unsigned j = 0; j < 16; ++j) { const unsigned c = xb_ld(&bar[XB_XCNT(j)]); sum += c; cnt += (c > 0u) ? 1u : 0u; mine = (j == x) ? c : mine; }
        if (sum == G) break;
        __builtin_amdgcn_s_sleep(1);
        if ((++sp & 255u) == 0u) { if (xb_ld(&bar[XB_TMO])) break; if (sp > XB_SPIN_CAP) { atomicAdd(&bar[XB_TMO], 1u); break; } }
    }
    nloc = mine > 0u ? mine : 1u; nx = cnt > 0u ? cnt : 1u;
}

__device__ __forceinline__ void xcd_barrier(const XcdBarrier& b) {
    asm volatile("s_waitcnt vmcnt(0)" ::: "memory");
    __syncthreads();
    if (threadIdx.x == 0) {
        unsigned* bar = b.bar;
        __builtin_amdgcn_s_waitcnt(0);
        unsigned nloc = b.st[0], nx = b.st[1];
        if (nloc == 0u) { xcd_barrier_complete(bar, b.x, nloc, nx); b.st[0] = nloc; b.st[1] = nx; }
        const unsigned old = xb_add(&bar[XB_XSUB(b.x)], 1u);
        const unsigned gen = old / nloc;
        if (old + 1u == (gen + 1u) * nloc) {
            __builtin_amdgcn_fence(__ATOMIC_RELEASE, "agent");
            asm volatile("s_waitcnt vmcnt(0)" ::: "memory");
            const unsigned og = xb_add(&bar[XB_TOP], 1u);
            const unsigned tg = og / nx;
            if (og + 1u == (tg + 1u) * nx) xb_add(&bar[XB_TOPGEN], 1u);
            else XB_SPIN(xb_ld(&bar[XB_TOPGEN]) == tg, bar);
            __builtin_amdgcn_fence(__ATOMIC_ACQUIRE, "agent");
            xb_add(&bar[XB_XGEN(b.x)], 1u);
            asm volatile("s_waitcnt vmcnt(0)" ::: "memory");
        } else {
            XB_SPIN(xb_ld(&bar[XB_XGEN(b.x)]) == gen, bar);
            __builtin_amdgcn_fence(__ATOMIC_ACQUIRE, "agent");
            asm volatile("s_waitcnt vmcnt(0)" ::: "memory");
        }
    }
    __syncthreads();
}


__global__ void __launch_bounds__(512, 2) fwd_mega(Params p) {
    extern __shared__ __attribute__((aligned(16))) unsigned char lds[];
    cg::grid_group grid = cg::this_grid();
    unsigned char* ws = p.ws; const int G = (int)gridDim.x, c = (int)blockIdx.x;
    PG8_LAS unsigned char* l3 = (PG8_LAS unsigned char*)lds;
    const int lo = p.ph_lo, hi = p.ph_hi;
#define IN(k) (lo <= (k) && (k) < hi)
    LAS unsigned* st = (LAS unsigned*)(l3 + ST_OFF);
    if (threadIdx.x == 0) { st[0] = 0u; st[1] = 0u; }
    __syncthreads();
    const XcdBarrier xbar = xcd_barrier_post((unsigned*)(ws + OFF_BAR), (volatile LAS unsigned*)st);
    if (hi > 1000) grid.sync();
#define SEAM(k) do { if (IN(k) && IN((k) + 1)) xcd_barrier(xbar); } while (0)
    if (IN(0)) { for (int rep = 0; rep < REP0; ++rep) { p0_prep(p, lds); __syncthreads(); } }
    SEAM(0);
    if (IN(1)) {
        { pg8::Gemm g{(const bf16_t*)(ws + OFF_WPO), (const bf16_t*)(ws + OFF_BPOOL), 1024, 512, 512, 512}; pg8::StaticOrder S; S.init(1024, 512, G, G - 1 - c);
          EpiPlain E{(bf16_t*)(ws + OFF_WEFF), 512}; pg8::gemm_phase<EpiPlain, pg8::StaticOrder, PG8_ALIGN, PG8_SP2>(l3, g, S, E); }
        { pg8::Gemm g{(const bf16_t*)(ws + OFF_R1), (const bf16_t*)(ws + OFF_WIN), MP, DIN, 1024, 1024}; EpiZ E{(bf16_t*)(ws + OFF_Z), (float*)(ws + OFF_SS)};
          { pg8::StaticOrder S; S.init(MP, DIN, G, c); pg8::gemm_phase<EpiZ, pg8::StaticOrder, PG8_ALIGN, PG8_SP2>(l3, g, S, E); }
          { SampleOrder S; S.init(MT - MP, DIN, G, G == 256 ? c - 128 : c); pg8::gemm_phase<EpiZ, SampleOrder, PG8_ALIGN, PG8_SP2>(l3, g, S, E); } }
    }
#if REP1 == 2
    if (IN(1)) {
        { pg8::Gemm g{(const bf16_t*)(ws + OFF_WPO), (const bf16_t*)(ws + OFF_BPOOL), 1024, 512, 512, 512}; pg8::StaticOrder S; S.init(1024, 512, G, G - 1 - c);
          EpiPlain E{(bf16_t*)(ws + OFF_WEFF), 512}; pg8::gemm_phase<EpiPlain, pg8::StaticOrder, PG8_ALIGN, PG8_SP2>(l3, g, S, E); }
        { pg8::Gemm g{(const bf16_t*)(ws + OFF_R1), (const bf16_t*)(ws + OFF_WIN), MT, DIN, 1024, 1024}; pg8::StaticOrder S; S.init(MT, DIN, G, c);
          EpiZ E{(bf16_t*)(ws + OFF_Z), (float*)(ws + OFF_SS)}; pg8::gemm_phase<EpiZ, pg8::StaticOrder, PG8_ALIGN, PG8_SP2>(l3, g, S, E); }
    }
#endif
    SEAM(1);
    if (IN(2)) { for (int rep = 0; rep < REP2; ++rep) { p2_mixer(p, lds); } }
    SEAM(2);
    if (IN(3)) {
        { pg8::Gemm g{(const bf16_t*)(ws + OFF_D), (const bf16_t*)(ws + OFF_WEFF), MP, 1024, 512, 512}; pg8::StaticOrder S; S.init(MP, 1024, G, c);
          EpiGate<0> E{(const bf16_t*)(ws + OFF_Z), (bf16_t*)(ws + OFF_MG), 1536}; pg8::gemm_phase<EpiGate<0>, pg8::StaticOrder, PG8_ALIGN, PG8_SP2>(l3, g, S, E); }
#ifndef DBG_SKIP_B
        { pg8::Gemm g{(const bf16_t*)(ws + OFF_S), (const bf16_t*)(ws + OFF_WSO), MP, 1024, 512, 512}; pg8::StaticOrder S; S.init(MP, 1024, G, c);
          EpiGate<1> E{(const bf16_t*)(ws + OFF_Z), (bf16_t*)(ws + OFF_MG), 2560}; pg8::gemm_phase<EpiGate<1>, pg8::StaticOrder, PG8_ALIGN, PG8_SP2>(l3, g, S, E); }
#endif
        small_ab(p);
    }
#if REP3 == 2
    if (IN(3)) {
        { pg8::Gemm g{(const bf16_t*)(ws + OFF_D), (const bf16_t*)(ws + OFF_WEFF), MP, 1024, 512, 512}; pg8::StaticOrder S; S.init(MP, 1024, G, c);
          EpiGate<0> E{(const bf16_t*)(ws + OFF_Z), (bf16_t*)(ws + OFF_MG), 1536}; pg8::gemm_phase<EpiGate<0>, pg8::StaticOrder, PG8_ALIGN, PG8_SP2>(l3, g, S, E); }
#ifndef DBG_SKIP_B
        { pg8::Gemm g{(const bf16_t*)(ws + OFF_S), (const bf16_t*)(ws + OFF_WSO), MP, 1024, 512, 512}; pg8::StaticOrder S; S.init(MP, 1024, G, c);
          EpiGate<1> E{(const bf16_t*)(ws + OFF_Z), (bf16_t*)(ws + OFF_MG), 2560}; pg8::gemm_phase<EpiGate<1>, pg8::StaticOrder, PG8_ALIGN, PG8_SP2>(l3, g, S, E); }
#endif
    }
#endif
    SEAM(3);
    if (IN(4)) {
        pg8::Gemm g{(const bf16_t*)(ws + OFF_MG), (const bf16_t*)(ws + OFF_WO), MP, 1024, 1024, 1024}; pg8::StaticOrder S; S.init(MP, 1024, G, c);
        if (G == 256) { EpiWoNorm E{p.in[I_XP], p.out + O_Y, (bf16_t*)(ws + OFF_R1), (float*)(ws + OFF_XS2), (unsigned*)(ws + OFF_CNT) + 64 * 64}; pg8::gemm_phase<EpiWoNorm, pg8::StaticOrder, false, PG8_SP2>(l3, g, S, E); }
        else { EpiRes<0> E{p.in[I_XP], p.in[I_XS], p.out + O_Y, (bf16_t*)(ws + OFF_R1), (float*)(ws + OFF_SS), p.out + O_Y}; pg8::gemm_phase<EpiRes<0>, pg8::StaticOrder, PG8_ALIGN, PG8_SP2>(l3, g, S, E); }
        small_o(p, lds);
    }
#if REP4 == 2
    if (IN(4)) {
        pg8::Gemm g{(const bf16_t*)(ws + OFF_MG), (const bf16_t*)(ws + OFF_WO), MP, 1024, 1024, 1024}; pg8::StaticOrder S; S.init(MP, 1024, G, c);
        EpiRes<0> E{p.in[I_XP], p.in[I_XS], p.out + O_Y, (bf16_t*)(ws + OFF_R1), (float*)(ws + OFF_SS), p.out + O_Y}; pg8::gemm_phase<EpiRes<0>, pg8::StaticOrder, PG8_ALIGN, PG8_SP2>(l3, g, S, E);
    }
#endif
    SEAM(4);
    if (IN(5)) {
        pg8::Gemm g{(const bf16_t*)(ws + OFF_R1), (const bf16_t*)(ws + OFF_WUG), MP, 2 * DFF, 1024, 1024};
        EpiUGConv E{(const float*)(ws + OFF_SS), (bf16_t*)(ws + OFF_G2), (float*)(ws + OFF_EA), (float*)(ws + OFF_EG), p.in[I_CW], p.in[I_CB], p.in[I_SCONV], p.out, (PG8_LAS float*)(l3 + HALO_OFF), G == 256 ? 1 : 0};
        { pg8::StaticOrder S; S.init(MP, 2 * DFF, G, c); pg8::gemm_phase<EpiUGConv, pg8::StaticOrder, PG8_ALIGN, PG8_SP2>(l3, g, S, E); }
        { SampleOrder S; S.init(MT - MP, 2 * DFF, G, G == 256 ? c - 128 : c); pg8::gemm_phase<EpiUGConv, SampleOrder, PG8_ALIGN, PG8_SP2>(l3, g, S, E); }
    }
    SEAM(5);
#if REP5 == 2
    grid.sync();
    if (IN(5)) {
        pg8::Gemm g{(const bf16_t*)(ws + OFF_R1), (const bf16_t*)(ws + OFF_WUG), MT, 2 * DFF, 1024, 1024}; pg8::StaticOrder S; S.init(MT, 2 * DFF, G, c);
        EpiUG E{(const float*)(ws + OFF_SS), (bf16_t*)(ws + OFF_A2), (bf16_t*)(ws + OFF_G2)}; pg8::gemm_phase<EpiUG, pg8::StaticOrder, PG8_ALIGN, PG8_SP2>(l3, g, S, E);
    }
    SEAM(5);
    if (IN(6)) p6_conv(p);
#endif
    if (IN(7)) {
#if REP7 == 2
        { pg8::Gemm g{(const bf16_t*)(ws + OFF_G2), (const bf16_t*)(ws + OFF_WD), MP, 1024, DFF, DFF}; pg8::StaticOrder S; S.init(MP, 1024, G, c);
          EpiRes<1> E{nullptr, nullptr, p.out + O_Y, nullptr, nullptr, (float*)(ws + OFF_A2)}; pg8::gemm_phase<EpiRes<1>, pg8::StaticOrder, PG8_ALIGN, PG8_SP2>(l3, g, S, E); xcd_barrier(xbar); }
#endif
        { pg8::Gemm g{(const bf16_t*)(ws + OFF_G2), (const bf16_t*)(ws + OFF_WD), MP, 1024, DFF, DFF}; pg8::StaticOrder S; S.init(MP, 1024, G, c);
          { Unit uu; for (int i = 0; S.next(i, uu); ++i) if ((uu.pm & 7) != 0) p6_fix(p, uu.pm); }
          if (G == 256) { EpiDownNorm E{p.out + O_Y, p.in[I_FNG], (float*)(ws + OFF_XS), (unsigned*)(ws + OFF_CNT)}; pg8::gemm_phase<EpiDownNorm, pg8::StaticOrder, false, PG8_SP2>(l3, g, S, E); }
          else { EpiRes<1> E{nullptr, nullptr, p.out + O_Y, nullptr, nullptr, p.out + O_Y}; pg8::gemm_phase<EpiRes<1>, pg8::StaticOrder, PG8_ALIGN, PG8_SP2>(l3, g, S, E); } }
        { pg8::Gemm g{(const bf16_t*)(ws + OFF_G2) + (size_t)MP * DFF, (const bf16_t*)(ws + OFF_WD), MT - MP, 1024, 256, DFF}; pg8::SplitKOrder S; S.init(MT - MP, 1024, 11, 256, G, c);
          EpiPartial E{(float*)(ws + OFF_A2), 256}; pg8::gemm_phase<EpiPartial, pg8::SplitKOrder, PG8_ALIGN, PG8_SP2>(l3, g, S, E); }
    }
    SEAM(7);
#if REP8 == 2
    if (IN(8)) { p8_final(p, (float*)(p.ws + OFF_G2), 0); xcd_barrier(xbar); }
#endif
    if (IN(8)) p8_final(p, p.out + O_Y, G == 256 ? MP / 8 : 0);
#if REPSYNC > 0
    grid.sync(); grid.sync(); grid.sync(); grid.sync(); grid.sync(); grid.sync(); grid.sync(); grid.sync();
#endif
#ifdef DBG_DUMP
    if (IN(9)) dbg_dump(p);
#endif
}

extern "C" void kernel_launch(void* const* d_in, const int* in_sizes, int n_in, void* d_out, int out_size, void* d_ws, size_t ws_size, hipStream_t stream) {
    static int grid_blocks = 0;
    if (!grid_blocks) {
        int dev = 0, cus = 0, per_cu = 0;
        (void)hipGetDevice(&dev);
        (void)hipDeviceGetAttribute(&cus, hipDeviceAttributeMultiprocessorCount, dev);
        (void)hipFuncSetAttribute((const void*)fwd_mega, hipFuncAttributeMaxDynamicSharedMemorySize, LDS_BYTES);
        (void)hipOccupancyMaxActiveBlocksPerMultiprocessor(&per_cu, (const void*)fwd_mega, 512, LDS_BYTES);
        if (per_cu < 1) per_cu = 1;
        grid_blocks = cus * per_cu;
        if (ws_size < WS_END + BAR_BYTES + CNT_BYTES) fprintf(stderr, "kernel_launch: workspace too small: %zu < %zu\n", ws_size, (size_t)WS_END);
    }
#ifdef DBG_MEMSET
    (void)hipMemsetAsync(d_ws, 0, WS_END, stream);
#endif
    (void)hipMemsetAsync((unsigned char*)d_ws + OFF_BAR, 0, BAR_BYTES + CNT_BYTES, stream);
    Params p{};
    for (int i = 0; i < 21; ++i) p.in[i] = (const float*)d_in[i];
    p.out = (float*)d_out; p.ws = (unsigned char*)d_ws;
#if N_LAUNCHES == 1
    p.ph_lo = 0; p.ph_hi = NPHASE;
    void* args[] = {&p};
    hipError_t e = hipLaunchCooperativeKernel((const void*)fwd_mega, dim3(grid_blocks), dim3(512), args, LDS_BYTES, stream);
    if (e != hipSuccess) fprintf(stderr, "cooperative launch failed: %s (grid %d)\n", hipGetErrorString(e), grid_blocks);
#else
    for (int k = 0; k < DBG_HI; ++k) { p.ph_lo = k; p.ph_hi = k + 1; hipLaunchKernelGGL(fwd_mega, dim3(grid_blocks), dim3(512), LDS_BYTES, stream, p); }
#ifdef DBG_DUMP
    p.ph_lo = 9; p.ph_hi = 10; hipLaunchKernelGGL(fwd_mega, dim3(grid_blocks), dim3(512), LDS_BYTES, stream, p);
#endif
#endif
}
```
